# Optimizing an MI355X kernel written in HIP

```python
import math
import jax, jax.numpy as jnp
from jax import lax
import numpy as np

D_MODEL = 1024
BATCH = 8
SEQ = 8192
DEPTH = 2
DEC_BATCH = 16
DEC_SEQ = 32
PAST_LEN = 4096

CHUNK = 64
D_SSM = D_MODEL // 2
SSM_GROUP = 16
N_GROUPS = D_SSM // SSM_GROUP
STATE = 64
N_HEADS = 8
HEAD_DIM = 64
D_ATT = N_HEADS * HEAD_DIM
IDX_HEADS = 8
IDX_DIM = 64
TOPK_MAX = 256
N_BRANCH = 2
EPS = 1e-6
DT_MIN = 1e-3
DT_MAX = 1e-1
SPLITS = (D_SSM, D_SSM, D_ATT, D_ATT, D_ATT, D_ATT, IDX_HEADS * IDX_DIM, IDX_DIM, IDX_HEADS, N_BRANCH * D_MODEL)
D_IN = 4 * D_ATT + 2 * D_SSM + IDX_HEADS * IDX_DIM + IDX_DIM + IDX_HEADS + N_BRANCH * D_MODEL

kernel_name = 'hybrid_s5_dsa_stream_step'

f32 = jnp.float32


def rms_norm(x, g):
    xf = x.astype(f32)
    return xf * lax.rsqrt(jnp.mean(xf * xf, axis=-1, keepdims=True) + EPS) * g.astype(f32)


def ssm_discretize(a_re, a_im, log_dt, b_re, b_im):
    a_re = a_re.astype(f32); a_im = a_im.astype(f32)
    dt = jnp.exp(log_dt.astype(f32))[:, None]
    mag = jnp.exp(a_re * dt); ang = a_im * dt
    ab_re = mag * jnp.cos(ang); ab_im = mag * jnp.sin(ang)
    den = a_re * a_re + a_im * a_im
    nr = ab_re - 1.0; ni = ab_im
    f_re = (nr * a_re + ni * a_im) / den
    f_im = (ni * a_re - nr * a_im) / den
    b_re = b_re.astype(f32); b_im = b_im.astype(f32)
    bb_re = f_re[..., None] * b_re - f_im[..., None] * b_im
    bb_im = f_re[..., None] * b_im + f_im[..., None] * b_re
    return ab_re, ab_im, bb_re, bb_im


def _cplx_combine(e1, e2):
    a1r, a1i, b1r, b1i = e1
    a2r, a2i, b2r, b2i = e2
    ar = a1r * a2r - a1i * a2i
    ai = a1r * a2i + a1i * a2r
    br = a2r * b1r - a2i * b1i + b2r
    bi = a2r * b1i + a2i * b1r + b2i
    return ar, ai, br, bi


def ssm_block(u, h_re, h_im, ab_re, ab_im, bb_re, bb_im, c_re, c_im, d_skip):
    bu_re = jnp.einsum('gpn,btgn->btgp', bb_re, u)
    bu_im = jnp.einsum('gpn,btgn->btgp', bb_im, u)
    bu_re = bu_re.at[:, 0].add(ab_re * h_re - ab_im * h_im)
    bu_im = bu_im.at[:, 0].add(ab_re * h_im + ab_im * h_re)
    a_re = jnp.broadcast_to(ab_re, bu_re.shape)
    a_im = jnp.broadcast_to(ab_im, bu_im.shape)
    _, _, hr, hi = lax.associative_scan(_cplx_combine, (a_re, a_im, bu_re, bu_im), axis=1)
    y = (jnp.einsum('gnp,btgp->btgn', c_re, hr) - jnp.einsum('gnp,btgp->btgn', c_im, hi)
         + d_skip * u)
    return y, hr[:, -1], hi[:, -1]


def ssm_scan(u, h_re, h_im, disc, c_re, c_im, d_skip):
    ab_re, ab_im, bb_re, bb_im = disc
    c_re = c_re.astype(f32); c_im = c_im.astype(f32); d_skip = d_skip.astype(f32)
    B_, T = u.shape[:2]
    if T > CHUNK and T % CHUNK == 0:
        n = T // CHUNK
        uc = jnp.moveaxis(u.reshape(B_, n, CHUNK, N_GROUPS, SSM_GROUP), 1, 0)

        def step(carry, u_c):
            hr, hi = carry
            y, hr, hi = ssm_block(u_c, hr, hi, ab_re, ab_im, bb_re, bb_im, c_re, c_im, d_skip)
            return (hr, hi), y

        (hr, hi), ys = lax.scan(step, (h_re, h_im), uc)
        return jnp.moveaxis(ys, 0, 1).reshape(B_, T, N_GROUPS, SSM_GROUP), hr, hi
    return ssm_block(u, h_re, h_im, ab_re, ab_im, bb_re, bb_im, c_re, c_im, d_skip)


def dsa_attend(q, qi, wi, k_all, v_all, ki_all, n_valid, n_sel):
    logits = jnp.einsum('bthd,bsd->bths', qi.astype(f32), ki_all.astype(f32)) * (IDX_DIM ** -0.5)
    score = jnp.einsum('bth,bths->bts', wi.astype(f32), jax.nn.relu(logits))
    S = k_all.shape[1]
    adm = jnp.arange(S) < n_valid
    score = jnp.where(adm[None, None, :], score, -jnp.inf)
    top_val, top_idx = lax.top_k(score, n_sel)
    valid = jnp.isfinite(top_val)
    gather = jax.vmap(lambda rows, idx: rows[idx])
    kg = gather(k_all, top_idx).astype(f32)
    vg = gather(v_all, top_idx).astype(f32)
    s = jnp.einsum('bthd,btkhd->bthk', q.astype(f32), kg) * (HEAD_DIM ** -0.5)
    s = jnp.where(valid[:, :, None, :], s, -jnp.inf)
    p = jax.nn.softmax(s, axis=-1)
    return jnp.einsum('bthk,btkhd->bthd', p, vg)


def layer(x, c, w_mod, b_mod, g_norm, w_in, a_re, a_im, log_dt, b_re, b_im, c_re, c_im, d_skip,
          w_glu, b_glu, w_ps, w_pa, w_o, h_re, h_im, past_k, past_v, past_ki):
    dtype = x.dtype
    B_, T = x.shape[:2]
    mod = jax.nn.silu(c.astype(f32)) @ w_mod.astype(f32) + b_mod.astype(f32)
    shift, scale, gate = jnp.split(mod, 3, axis=-1)
    h = rms_norm(x, g_norm) * (1.0 + scale[:, None]) + shift[:, None]
    z = jnp.einsum('btd,de->bte', h, w_in.astype(f32))
    offs = list(np.cumsum(SPLITS)[:-1])
    u, zs, q, k, v, za, qi, ki, wi, gm = jnp.split(z, offs, axis=-1)

    disc = ssm_discretize(a_re, a_im, log_dt, b_re, b_im)
    us = u.reshape(B_, T, N_GROUPS, SSM_GROUP)
    ys, hr, hi = ssm_scan(us, h_re.astype(f32), h_im.astype(f32), disc, c_re, c_im, d_skip)
    ys = jax.nn.gelu(ys.reshape(B_, T, D_SSM))
    ys = ys * jax.nn.sigmoid(ys @ w_glu.astype(f32) + b_glu.astype(f32))
    ys = ys * jax.nn.silu(zs)

    q = q.reshape(B_, T, N_HEADS, HEAD_DIM)
    k = k.reshape(B_, T, N_HEADS, HEAD_DIM)
    v = v.reshape(B_, T, N_HEADS, HEAD_DIM)
    qi = qi.reshape(B_, T, IDX_HEADS, IDX_DIM)
    wi = wi * (IDX_HEADS ** -0.5)
    if past_k is None:
        n_sel = min(TOPK_MAX, T // 4)

        def one_chunk(ci):
            q0 = ci * CHUNK
            sl = lambda a: lax.dynamic_slice_in_dim(a, q0, CHUNK, axis=1)
            return dsa_attend(sl(q), sl(qi), sl(wi), k, v, ki, q0 + CHUNK, n_sel)

        o = lax.map(one_chunk, jnp.arange(T // CHUNK))
        o = jnp.moveaxis(o, 0, 1).reshape(B_, T, N_HEADS, HEAD_DIM)
    else:
        k_all = jnp.concatenate([past_k.astype(f32), k], axis=1)
        v_all = jnp.concatenate([past_v.astype(f32), v], axis=1)
        ki_all = jnp.concatenate([past_ki.astype(f32), ki], axis=1)
        L = k_all.shape[1]
        o = dsa_attend(q, qi, wi, k_all, v_all, ki_all, L, min(TOPK_MAX, L // 4))
    ya = o.reshape(B_, T, D_ATT) * jax.nn.silu(za)

    g_s, g_a = jnp.split(gm, N_BRANCH, axis=-1)
    merged = (jax.nn.sigmoid(g_s) * (ys @ w_ps.astype(f32))
              + jax.nn.sigmoid(g_a) * (ya @ w_pa.astype(f32)))
    out = merged @ w_o.astype(f32)
    x_new = (x.astype(f32) + gate[:, None] * out).astype(dtype)
    return x_new, (k.astype(dtype), v.astype(dtype), ki.astype(dtype), hr, hi)


def setup_inputs(seed: int = 0) -> dict:
    key = jax.random.key(seed)
    ks = jax.random.split(key, 32)
    nrm = lambda i, shape, s: jax.random.normal(ks[i], shape, f32) * s
    n_idx = jnp.arange(STATE, dtype=f32)
    return {
        'x_prompt': nrm(0, (BATCH, SEQ, D_MODEL), 1.0),
        'x_sample': nrm(1, (DEC_BATCH, DEC_SEQ, D_MODEL), 1.0),
        'cache_k': nrm(2, (DEPTH, DEC_BATCH, PAST_LEN, N_HEADS, HEAD_DIM), 1.0),
        'cache_v': nrm(3, (DEPTH, DEC_BATCH, PAST_LEN, N_HEADS, HEAD_DIM), 1.0),
        'cache_kidx': nrm(4, (DEPTH, DEC_BATCH, PAST_LEN, IDX_DIM), 1.0),
        'state_ssm_re': nrm(5, (DEPTH, DEC_BATCH, N_GROUPS, STATE), 0.5),
        'state_ssm_im': nrm(6, (DEPTH, DEC_BATCH, N_GROUPS, STATE), 0.5),
        'c_prompt': nrm(7, (BATCH, D_MODEL), 1.0),
        'c_sample': nrm(8, (DEC_BATCH, D_MODEL), 1.0),
        'w_mod': nrm(9, (DEPTH, D_MODEL, 3 * D_MODEL), 0.5 * D_MODEL ** -0.5),
        'b_mod': nrm(10, (DEPTH, 3 * D_MODEL), 0.01),
        'g_norm': 1.0 + nrm(11, (DEPTH, D_MODEL), 0.01),
        'w_in': nrm(12, (DEPTH, D_MODEL, D_IN), D_MODEL ** -0.5),
        'a_re': -0.5 + nrm(13, (DEPTH, N_GROUPS, STATE), 0.01),
        'a_im': math.pi * n_idx + nrm(14, (DEPTH, N_GROUPS, STATE), 0.01),
        'log_dt': jax.random.uniform(ks[15], (DEPTH, N_GROUPS), f32, math.log(DT_MIN), math.log(DT_MAX)),
        'b_re': nrm(16, (DEPTH, N_GROUPS, STATE, SSM_GROUP), (2 * SSM_GROUP) ** -0.5),
        'b_im': nrm(17, (DEPTH, N_GROUPS, STATE, SSM_GROUP), (2 * SSM_GROUP) ** -0.5),
        'c_re': nrm(18, (DEPTH, N_GROUPS, SSM_GROUP, STATE), STATE ** -0.5),
        'c_im': nrm(19, (DEPTH, N_GROUPS, SSM_GROUP, STATE), STATE ** -0.5),
        'd_skip': nrm(20, (DEPTH, N_GROUPS, SSM_GROUP), 1.0),
        'w_glu': nrm(21, (DEPTH, D_SSM, D_SSM), D_SSM ** -0.5),
        'b_glu': nrm(22, (DEPTH, D_SSM), 0.01),
        'w_ps': nrm(23, (DEPTH, D_SSM, D_MODEL), D_SSM ** -0.5),
        'w_pa': nrm(24, (DEPTH, D_ATT, D_MODEL), D_ATT ** -0.5),
        'w_o': nrm(25, (DEPTH, D_MODEL, D_MODEL), D_MODEL ** -0.5),
        'g_final': 1.0 + nrm(26, (D_MODEL,), 0.01),
    }


def reference(x_prompt, x_sample, cache_k, cache_v, cache_kidx, state_ssm_re, state_ssm_im,
              c_prompt, c_sample, w_mod, b_mod, g_norm, w_in, a_re, a_im, log_dt, b_re, b_im,
              c_re, c_im, d_skip, w_glu, b_glu, w_ps, w_pa, w_o, g_final):
    xp, xs = x_prompt, x_sample
    kp, vp, kip, srp, sip = [], [], [], [], []
    kss, vss, kis, srs, sis = [], [], [], [], []
    zeros = jnp.zeros((x_prompt.shape[0], N_GROUPS, STATE), f32)
    for l in range(DEPTH):
        lw = (w_mod[l], b_mod[l], g_norm[l], w_in[l], a_re[l], a_im[l], log_dt[l], b_re[l], b_im[l],
              c_re[l], c_im[l], d_skip[l], w_glu[l], b_glu[l], w_ps[l], w_pa[l], w_o[l])
        xp, (k1, v1, ki1, hr1, hi1) = layer(xp, c_prompt, *lw, zeros, zeros, None, None, None)
        xs, (k2, v2, ki2, hr2, hi2) = layer(xs, c_sample, *lw, state_ssm_re[l], state_ssm_im[l],
                                            cache_k[l], cache_v[l], cache_kidx[l])
        kp.append(k1); vp.append(v1); kip.append(ki1); srp.append(hr1); sip.append(hi1)
        kss.append(k2); vss.append(v2); kis.append(ki2); srs.append(hr2); sis.append(hi2)
    y_prompt = rms_norm(xp, g_final).astype(x_prompt.dtype)
    y_sample = rms_norm(xs, g_final).astype(x_sample.dtype)
    return (y_prompt, y_sample,
            jnp.stack(kp), jnp.stack(vp), jnp.stack(kip), jnp.stack(srp), jnp.stack(sip),
            jnp.stack(kss), jnp.stack(vss), jnp.stack(kis), jnp.stack(srs), jnp.stack(sis))
```

```cpp
#include <hip/hip_runtime.h>
#include <hip/hip_cooperative_groups.h>
#include <stdint.h>
#include <stdio.h>
namespace cg = cooperative_groups;

#ifndef MULTI_LAUNCH
#define MULTI_LAUNCH 0
#endif

#define DI __device__ __forceinline__
typedef __attribute__((ext_vector_type(8))) short bf16x8;
typedef __attribute__((ext_vector_type(4))) float f32x4;
typedef unsigned short u16;
typedef __attribute__((ext_vector_type(4))) unsigned u32x4;
typedef __attribute__((ext_vector_type(2))) unsigned u32x2;

constexpr int NP = 65536, NS = 512, NTOK = NP + NS;
constexpr int D_IN = 5704, N_IN1 = 3656, N_IN1P = 3712;
constexpr int KS_ROWS = 4160, KIS_ROWS = 4128, MS_ROW = 264;
constexpr int LDS_BYTES = 73728;
constexpr int NPHASE = 18;

constexpr size_t O_KP = 67633152, O_VP = 134742016, O_KIP = 201850880, O_SRP = 210239488, O_SIP = 210272256,
                 O_KS = 210305024, O_VS = 210829312, O_KIS = 211353600, O_SRS = 211419136, O_SIS = 211484672;

struct Params {
  const float *x_prompt, *x_sample, *cache_k, *cache_v, *cache_kidx, *st_re, *st_im, *c_prompt, *c_sample;
  const float *w_mod, *b_mod, *g_norm, *w_in, *a_re, *a_im, *log_dt, *b_re, *b_im, *c_re, *c_im, *d_skip;
  const float *w_glu, *b_glu, *w_ps, *w_pa, *w_o, *g_final;
  float* out;
  char* ws;
  int phase_lo, phase_hi;
};
constexpr size_t al256(size_t x) { return (x + 255) & ~(size_t)255; }
constexpr size_t WS_WinT = 0;
constexpr size_t WS_WgT = WS_WinT + al256((size_t)2 * N_IN1P * 1024 * 2);
constexpr size_t WS_WgluT = WS_WgT + al256((size_t)2 * 2048 * 1024 * 2);
constexpr size_t WS_WpsT = WS_WgluT + al256((size_t)2 * 512 * 512 * 2);
constexpr size_t WS_WpaT = WS_WpsT + al256((size_t)2 * 1024 * 512 * 2);
constexpr size_t WS_WoT = WS_WpaT + al256((size_t)2 * 1024 * 512 * 2);
constexpr size_t WS_mod = WS_WoT + al256((size_t)2 * 1024 * 1024 * 2);
constexpr size_t WS_ab = WS_mod + al256((size_t)2 * 24 * 3072 * 4);
constexpr size_t WS_Bmat = WS_ab + al256((size_t)2 * 32 * 64 * 2 * 4);
constexpr size_t WS_Cmat = WS_Bmat + al256((size_t)2 * 32 * 128 * 16 * 2);
constexpr size_t WS_H = WS_Cmat + al256((size_t)2 * 32 * 16 * 128 * 2);
constexpr size_t WS_U = WS_H + al256((size_t)NTOK * 1024 * 2);
constexpr size_t WS_QI = WS_U + (size_t)NTOK * 512 * 2;
constexpr size_t WS_ZS = WS_QI + al256((size_t)NTOK * 512 * 2);
constexpr size_t WS_Q = WS_ZS + al256((size_t)NTOK * 512 * 2);
constexpr size_t WS_ZA = WS_Q + al256((size_t)NTOK * 512 * 2);
constexpr size_t WS_Kp = WS_ZA + al256((size_t)NTOK * 512 * 2);
constexpr size_t WS_VTp = WS_Kp + al256((size_t)NP * 512 * 2);
constexpr size_t WS_KIp = WS_VTp + al256((size_t)NP * 512 * 2);
constexpr size_t WS_Ks = WS_KIp + al256((size_t)NP * 64 * 2);
constexpr size_t WS_VTs = WS_Ks + al256((size_t)16 * KS_ROWS * 512 * 2);
constexpr size_t WS_KIs = WS_VTs + al256((size_t)16 * 512 * KS_ROWS * 2);
constexpr size_t WS_WI = WS_KIs + al256((size_t)16 * KIS_ROWS * 64 * 2);
constexpr size_t WS_SlocR = WS_WI + al256((size_t)NTOK * 8 * 4);
constexpr size_t WS_SlocI = WS_SlocR + al256((size_t)8 * 128 * 32 * 64 * 4);
constexpr size_t WS_HstR = WS_SlocI + al256((size_t)8 * 128 * 32 * 64 * 4);
constexpr size_t WS_HstI = WS_HstR + al256((size_t)8 * 128 * 32 * 64 * 4);
constexpr size_t WS_maskp = WS_HstI + al256((size_t)8 * 128 * 32 * 64 * 4);
constexpr size_t WS_masks = WS_maskp + al256((size_t)NP * 512 * 2);
constexpr size_t WS_BbF = WS_masks + al256((size_t)NS * MS_ROW * 2);
constexpr size_t WS_TOTAL = WS_BbF + al256((size_t)64 * 2 * 16 * 64 * 4);

DI u16 f2bf(float x) { uint32_t u = __float_as_uint(x); u += 0x7fffu + ((u >> 16) & 1u); return (u16)(u >> 16); }
DI float bf2f(u16 h) { return __uint_as_float(((uint32_t)h) << 16); }
DI uint32_t pack2(float a, float b) { return (uint32_t)f2bf(a) | ((uint32_t)f2bf(b) << 16); }
DI float sigmoidf_(float x) { return 1.f / (1.f + __expf(-x)); }
DI float siluf_(float x) { return x * sigmoidf_(x); }
DI float geluf_(float v) { return v * sigmoidf_(1.5957691216f * (v + 0.044715f * v * v * v)); }
DI float wave_sum(float v) {
#pragma unroll
  for (int o = 32; o > 0; o >>= 1) v += __shfl_xor(v, o);
  return v;
}
DI int tidx() { int t = threadIdx.x; asm volatile("" : "+v"(t)); return t; }
DI void wave_lds_sync() { asm volatile("s_waitcnt lgkmcnt(0)" ::: "memory"); }
DI f32x4 mfma16(bf16x8 a, bf16x8 b, f32x4 c) { return __builtin_amdgcn_mfma_f32_16x16x32_bf16(a, b, c, 0, 0, 0); }
typedef _Float16 f16x8 __attribute__((ext_vector_type(8)));
DI f32x4 mfma16h(bf16x8 a, bf16x8 b, f32x4 c) { return __builtin_amdgcn_mfma_f32_16x16x32_f16(__builtin_bit_cast(f16x8, a), __builtin_bit_cast(f16x8, b), c, 0, 0, 0); }
DI u16 f2h(float x) { const _Float16 h = (_Float16)x; return __builtin_bit_cast(u16, h); }
DI uint32_t pack2h(float a, float b) { return (uint32_t)f2h(a) | ((uint32_t)f2h(b) << 16); }
DI bf16x8 ldg8(const u16* p) { return *reinterpret_cast<const bf16x8*>(p); }
DI bf16x8 zero8() { bf16x8 z = {0, 0, 0, 0, 0, 0, 0, 0}; return z; }

DI const float* xin_row(const Params& p, int l, int R) {
  if (l == 0) return R < NP ? p.x_prompt + (size_t)R * 1024 : p.x_sample + (size_t)(R - NP) * 1024;
  return p.out + (size_t)R * 1024;
}
DI int batch_of(int R) { return R < NP ? (R >> 13) : 8 + ((R - NP) >> 5); }

template <int NT, bool F16 = false>
DI void gemm_accum(f32x4 (&acc)[4][NT], const u16* __restrict__ A, int lda, const u16* __restrict__ Bt, int ldb, int K, u16* lds) {
  constexpr int LR = 72;
  constexpr int BN = 32 * NT;
  constexpr int NBCH = BN / 32;
  constexpr int BUF = 256 * LR;
  const int tid = tidx(), lane = tid & 63, wave = tid >> 6, wr = wave >> 1, wc = wave & 1, fr = lane & 15, fq = lane >> 4;
  u32x4 ra[4], rb[NBCH];
  const int crow = tid >> 3, cch = tid & 7;
  const u16* Ap = A + (size_t)crow * lda + cch * 8;
  const u16* Bp = Bt + (size_t)crow * ldb + cch * 8;
  const int nk = K >> 6;
  auto gload = [&](int kt) {
    const int k0 = kt << 6;
#pragma unroll
    for (int i = 0; i < 4; ++i) ra[i] = *reinterpret_cast<const u32x4*>(Ap + (size_t)(i * 32) * lda + k0);
#pragma unroll
    for (int i = 0; i < NBCH; ++i) rb[i] = *reinterpret_cast<const u32x4*>(Bp + (size_t)(i * 32) * ldb + k0);
  };
  auto lstore = [&](int buf) {
    u16* sA = lds + buf * BUF;
    u16* sB = sA + 128 * LR;
#pragma unroll
    for (int i = 0; i < 4; ++i) *reinterpret_cast<u32x4*>(sA + (crow + i * 32) * LR + cch * 8) = ra[i];
#pragma unroll
    for (int i = 0; i < NBCH; ++i) *reinterpret_cast<u32x4*>(sB + (crow + i * 32) * LR + cch * 8) = rb[i];
  };
  gload(0);
  __syncthreads();
  lstore(0);
  if (nk > 1) gload(1);
  __syncthreads();
  for (int kt = 0; kt < nk; ++kt) {
    const int cur = kt & 1;
    if (kt + 1 < nk) lstore(cur ^ 1);
    if (kt + 2 < nk) gload(kt + 2);
    const u16* sA = lds + cur * BUF;
    const u16* sB = sA + 128 * LR;
#pragma unroll
    for (int ks = 0; ks < 2; ++ks) {
      bf16x8 a[4], b[NT];
#pragma unroll
      for (int m = 0; m < 4; ++m) a[m] = *reinterpret_cast<const bf16x8*>(sA + (wr * 64 + m * 16 + fr) * LR + ks * 32 + fq * 8);
#pragma unroll
      for (int n = 0; n < NT; ++n) b[n] = *reinterpret_cast<const bf16x8*>(sB + (wc * 16 * NT + n * 16 + fr) * LR + ks * 32 + fq * 8);
#pragma unroll
      for (int m = 0; m < 4; ++m)
#pragma unroll
        for (int n = 0; n < NT; ++n) acc[m][n] = F16 ? mfma16h(a[m], b[n], acc[m][n]) : mfma16(a[m], b[n], acc[m][n]);
    }
    __syncthreads();
  }
}
template <int NT>
DI void zero_acc(f32x4 (&acc)[4][NT]) {
#pragma unroll
  for (int m = 0; m < 4; ++m)
#pragma unroll
    for (int n = 0; n < NT; ++n) acc[m][n] = f32x4{0.f, 0.f, 0.f, 0.f};
}


struct GemmOrder {
  int x, j, nb, cnt, NN, k;
  DI void init(int nM, int NN_) { x = blockIdx.x & 7; j = blockIdx.x >> 3; nb = gridDim.x >> 3; cnt = (nM - x + 7) >> 3; NN = NN_; k = 0; }
  DI bool next(int& mt, int& nt) {
    for (;;) {
      const int s = j + nb * k; ++k;
      const int g = s / (4 * NN), r = s - g * (4 * NN);
      if (g * 4 >= cnt) return false;
      const int i = g * 4 + (r & 3);
      if (i >= cnt) continue;
      mt = x + 8 * i; nt = r >> 2; return true;
    }
  }
};
template <bool F16>
DI void transpose_w(const float* __restrict__ W, int K, int N, int n0, int ncount, u16* __restrict__ WT, int gtid, int gstride) {
  const int total = ncount * (K >> 3);
  for (int idx = gtid; idx < total; idx += gstride) {
    const int n = idx % ncount, kb = idx / ncount;
    const float* src = W + (size_t)(kb * 8) * N + n0 + n;
    float f[8];
#pragma unroll
    for (int j = 0; j < 8; ++j) f[j] = src[(size_t)j * N];
    uint4 o;
    if (F16) { o.x = pack2h(f[0], f[1]); o.y = pack2h(f[2], f[3]); o.z = pack2h(f[4], f[5]); o.w = pack2h(f[6], f[7]); }
    else { o.x = pack2(f[0], f[1]); o.y = pack2(f[2], f[3]); o.z = pack2(f[4], f[5]); o.w = pack2(f[6], f[7]); }
    *reinterpret_cast<uint4*>(WT + (size_t)n * K + kb * 8) = o;
  }
}

__device__ void phase_prep(const Params& p, char* lds) {
  const int gtid = blockIdx.x * 256 + tidx(), gstride = gridDim.x * 256;
  for (int l = 0; l < 2; ++l) {
    transpose_w<true>(p.w_in + (size_t)l * 1024 * D_IN, 1024, D_IN, 0, N_IN1, ((u16*)(p.ws + WS_WinT)) + (size_t)l * N_IN1P * 1024, gtid, gstride);
    transpose_w<true>(p.w_in + (size_t)l * 1024 * D_IN, 1024, D_IN, N_IN1, 2048, ((u16*)(p.ws + WS_WgT)) + (size_t)l * 2048 * 1024, gtid, gstride);
    transpose_w<false>(p.w_glu + (size_t)l * 512 * 512, 512, 512, 0, 512, ((u16*)(p.ws + WS_WgluT)) + (size_t)l * 512 * 512, gtid, gstride);
    transpose_w<false>(p.w_ps + (size_t)l * 512 * 1024, 512, 1024, 0, 1024, ((u16*)(p.ws + WS_WpsT)) + (size_t)l * 1024 * 512, gtid, gstride);
    transpose_w<false>(p.w_pa + (size_t)l * 512 * 1024, 512, 1024, 0, 1024, ((u16*)(p.ws + WS_WpaT)) + (size_t)l * 1024 * 512, gtid, gstride);
    transpose_w<false>(p.w_o + (size_t)l * 1024 * 1024, 1024, 1024, 0, 1024, ((u16*)(p.ws + WS_WoT)) + (size_t)l * 1024 * 1024, gtid, gstride);
  }
  for (int idx = gtid; idx < 2 * 32 * 64; idx += gstride) {
    const int lg = idx >> 6, pp = idx & 63;
    const float are = p.a_re[idx], aim = p.a_im[idx];
    const float dt = expf(p.log_dt[lg]);
    const float mag = expf(are * dt), ang = aim * dt;
    const float kk = rintf(ang * 0.15915494309189535f);
    float r = fmaf(-kk, 6.2831854820251465f, ang);
    r = fmaf(-kk, -1.7484556e-07f, r);
    const float cs = cosf(r), sn = sinf(r);
    const float abr = mag * cs, abi = mag * sn;
    const float den = are * are + aim * aim;
    const float nr = abr - 1.f, ni = abi;
    const float fre = (nr * are + ni * aim) / den, fim = (ni * are - nr * aim) / den;
    ((float*)(p.ws + WS_ab))[idx * 2] = abr; ((float*)(p.ws + WS_ab))[idx * 2 + 1] = abi;
#pragma unroll
    for (int n = 0; n < 16; ++n) {
      const float br = p.b_re[(size_t)idx * 16 + n], bi = p.b_im[(size_t)idx * 16 + n];
      ((float*)(p.ws + WS_BbF))[(((size_t)lg * 2 + 0) * 16 + n) * 64 + pp] = fre * br - fim * bi;
      ((float*)(p.ws + WS_BbF))[(((size_t)lg * 2 + 1) * 16 + n) * 64 + pp] = fre * bi + fim * br;
      ((u16*)(p.ws + WS_Bmat))[((size_t)lg * 128 + pp) * 16 + n] = f2bf(fre * br - fim * bi);
      ((u16*)(p.ws + WS_Bmat))[((size_t)lg * 128 + 64 + pp) * 16 + n] = f2bf(fre * bi + fim * br);
      ((u16*)(p.ws + WS_Cmat))[((size_t)lg * 16 + n) * 128 + pp] = f2bf(p.c_re[((size_t)lg * 16 + n) * 64 + pp]);
      ((u16*)(p.ws + WS_Cmat))[((size_t)lg * 16 + n) * 128 + 64 + pp] = f2bf(-p.c_im[((size_t)lg * 16 + n) * 64 + pp]);
    }
  }
  float* red = reinterpret_cast<float*>(lds);
  for (int u = blockIdx.x; u < 192; u += gridDim.x) {
    const int l = u / 96, cg_ = u % 96;
    const int col = tidx() & 31, ks = tidx() >> 5;
    float acc[24];
#pragma unroll
    for (int r = 0; r < 24; ++r) acc[r] = 0.f;
    const float* wm = p.w_mod + (size_t)l * 1024 * 3072 + cg_ * 32 + col;
    for (int k = ks * 128; k < ks * 128 + 128; ++k) {
      const float w = wm[(size_t)k * 3072];
#pragma unroll
      for (int r = 0; r < 24; ++r) {
        const float c = r < 8 ? p.c_prompt[r * 1024 + k] : p.c_sample[(r - 8) * 1024 + k];
        acc[r] = fmaf(siluf_(c), w, acc[r]);
      }
    }
    __syncthreads();
#pragma unroll
    for (int r = 0; r < 24; ++r) red[(ks * 24 + r) * 32 + col] = acc[r];
    __syncthreads();
    for (int o = tidx(); o < 768; o += 256) {
      const int r = o >> 5, c = o & 31;
      float s = p.b_mod[l * 3072 + cg_ * 32 + c];
#pragma unroll
      for (int k8 = 0; k8 < 8; ++k8) s += red[(k8 * 24 + r) * 32 + c];
      ((float*)(p.ws + WS_mod))[((size_t)l * 24 + r) * 3072 + cg_ * 32 + c] = s;
    }
  }
}

__device__ void phase_norm(const Params& p, int l) {
  const int wave = tidx() >> 6, lane = tidx() & 63;
  const int gw = blockIdx.x * 4 + wave, nw = gridDim.x * 4;
  const float* gn = p.g_norm + l * 1024;
  for (int R = gw; R < NTOK; R += nw) {
    const float* x = xin_row(p, l, R);
    float4 v[4];
    float ss = 0.f;
#pragma unroll
    for (int i = 0; i < 4; ++i) {
      v[i] = *reinterpret_cast<const float4*>(x + i * 256 + lane * 4);
      ss += v[i].x * v[i].x + v[i].y * v[i].y + v[i].z * v[i].z + v[i].w * v[i].w;
    }
    ss = wave_sum(ss);
    const float rstd = rsqrtf(ss * (1.f / 1024.f) + 1e-6f);
    const float* md = ((float*)(p.ws + WS_mod)) + ((size_t)l * 24 + batch_of(R)) * 3072;
#pragma unroll
    for (int i = 0; i < 4; ++i) {
      const int c = i * 256 + lane * 4;
      const float4 g4 = *reinterpret_cast<const float4*>(gn + c);
      const float4 sh = *reinterpret_cast<const float4*>(md + c);
      const float4 sc = *reinterpret_cast<const float4*>(md + 1024 + c);
      uint2 o;
      o.x = pack2h(v[i].x * rstd * g4.x * (1.f + sc.x) + sh.x, v[i].y * rstd * g4.y * (1.f + sc.y) + sh.y);
      o.y = pack2h(v[i].z * rstd * g4.z * (1.f + sc.z) + sh.z, v[i].w * rstd * g4.w * (1.f + sc.w) + sh.w);
      *reinterpret_cast<uint2*>(((u16*)(p.ws + WS_H)) + (size_t)R * 1024 + c) = o;
    }
  }
  const int gtid = blockIdx.x * 256 + tidx(), gstride = gridDim.x * 256;
  {
    const float* ck = p.cache_k + (size_t)l * 16 * 4096 * 512;
    for (int idx = gtid; idx < 16 * 4096 * 512 / 8; idx += gstride) {
      const size_t e = (size_t)idx * 8;
      const int b = (int)(e / (4096 * 512)), rem = (int)(e % (4096 * 512));
      const float4 a = *reinterpret_cast<const float4*>(ck + e), c = *reinterpret_cast<const float4*>(ck + e + 4);
      uint4 o; o.x = pack2(a.x, a.y); o.y = pack2(a.z, a.w); o.z = pack2(c.x, c.y); o.w = pack2(c.z, c.w);
      *reinterpret_cast<uint4*>(((u16*)(p.ws + WS_Ks)) + (size_t)b * KS_ROWS * 512 + rem) = o;
    }
    const float* cki = p.cache_kidx + (size_t)l * 16 * 4096 * 64;
    for (int idx = gtid; idx < 16 * 4096 * 64 / 8; idx += gstride) {
      const size_t e = (size_t)idx * 8;
      const int b = (int)(e / (4096 * 64)), rem = (int)(e % (4096 * 64));
      const float4 a = *reinterpret_cast<const float4*>(cki + e), c = *reinterpret_cast<const float4*>(cki + e + 4);
      uint4 o; o.x = pack2h(a.x, a.y); o.y = pack2h(a.z, a.w); o.z = pack2h(c.x, c.y); o.w = pack2h(c.z, c.w);
      *reinterpret_cast<uint4*>(((u16*)(p.ws + WS_KIs)) + (size_t)b * KIS_ROWS * 64 + rem) = o;
    }
    const float* cv = p.cache_v + (size_t)l * 16 * 4096 * 512;
    for (int idx = gtid; idx < 16 * 512 * 512; idx += gstride) {
      const int c = idx & 511, sb = (idx >> 9) & 511, b = idx >> 18;
      const float* src = cv + ((size_t)b * 4096 + sb * 8) * 512 + c;
      float f[8];
#pragma unroll
      for (int j = 0; j < 8; ++j) f[j] = src[(size_t)j * 512];
      uint4 o; o.x = pack2(f[0], f[1]); o.y = pack2(f[2], f[3]); o.z = pack2(f[4], f[5]); o.w = pack2(f[6], f[7]);
      *reinterpret_cast<uint4*>(((u16*)(p.ws + WS_VTs)) + ((size_t)b * 512 + c) * KS_ROWS + sb * 8) = o;
    }
  }
}

__device__ void phase_inproj(const Params& p, int l, char* lds) {
  const int lane = tidx() & 63, wave = tidx() >> 6, wr = wave >> 1, wc = wave & 1, fr = lane & 15, fq = lane >> 4;
  GemmOrder ord; ord.init(NTOK / 128, 29);
  int mt, nt;
  while (ord.next(mt, nt)) {
    f32x4 acc[4][4];
    zero_acc<4>(acc);
    gemm_accum<4, true>(acc, ((u16*)(p.ws + WS_H)) + (size_t)mt * 128 * 1024, 1024, ((u16*)(p.ws + WS_WinT)) + ((size_t)l * N_IN1P + nt * 128) * 1024, 1024, 1024, reinterpret_cast<u16*>(lds));
    const int region = nt >> 2;
#pragma unroll
    for (int m = 0; m < 4; ++m) {
      const int R0 = mt * 128 + wr * 64 + m * 16 + fq * 4;
      const bool smp = R0 >= NP;
      const int rs = R0 - NP;
      const int b = smp ? (rs >> 5) : (R0 >> 13);
      const int s0 = smp ? (rs & 31) : (R0 & 8191);
#pragma unroll
      for (int n = 0; n < 4; ++n) {
        const int C = nt * 128 + wc * 64 + n * 16 + fr;
        const f32x4 v = acc[m][n];
        if (region == 0) {
#pragma unroll
          for (int j = 0; j < 4; ++j) ((u16*)(p.ws + WS_U))[(size_t)(R0 + j) * 512 + C] = f2bf(v[j]);
        } else if (region == 1) {
#pragma unroll
          for (int j = 0; j < 4; ++j) ((u16*)(p.ws + WS_ZS))[(size_t)(R0 + j) * 512 + (C - 512)] = f2bf(siluf_(v[j]));
        } else if (region == 2) {
#pragma unroll
          for (int j = 0; j < 4; ++j) ((u16*)(p.ws + WS_Q))[(size_t)(R0 + j) * 512 + (C - 1024)] = f2bf(v[j] * 0.18033688011112042f);
        } else if (region == 3) {
          const int cc = C - 1536;
          float* of = smp ? p.out + O_KS + (size_t)l * 262144 + (size_t)rs * 512 + cc : p.out + O_KP + (size_t)l * 33554432 + (size_t)R0 * 512 + cc;
          u16* ob = smp ? ((u16*)(p.ws + WS_Ks)) + ((size_t)b * KS_ROWS + 4096 + s0) * 512 + cc : ((u16*)(p.ws + WS_Kp)) + (size_t)R0 * 512 + cc;
#pragma unroll
          for (int j = 0; j < 4; ++j) { of[(size_t)j * 512] = v[j]; ob[(size_t)j * 512] = f2bf(v[j]); }
        } else if (region == 4) {
          const int cc = C - 2048;
          float* of = smp ? p.out + O_VS + (size_t)l * 262144 + (size_t)rs * 512 + cc : p.out + O_VP + (size_t)l * 33554432 + (size_t)R0 * 512 + cc;
#pragma unroll
          for (int j = 0; j < 4; ++j) of[(size_t)j * 512] = v[j];
          uint2 o; o.x = pack2(v[0], v[1]); o.y = pack2(v[2], v[3]);
          u16* ob = smp ? ((u16*)(p.ws + WS_VTs)) + ((size_t)b * 512 + cc) * KS_ROWS + 4096 + s0 : ((u16*)(p.ws + WS_VTp)) + ((size_t)b * 512 + cc) * 8192 + s0;
          *reinterpret_cast<uint2*>(ob) = o;
        } else if (region == 5) {
#pragma unroll
          for (int j = 0; j < 4; ++j) ((u16*)(p.ws + WS_ZA))[(size_t)(R0 + j) * 512 + (C - 2560)] = f2bf(siluf_(v[j]));
        } else if (region == 6) {
#pragma unroll
          for (int j = 0; j < 4; ++j) ((u16*)(p.ws + WS_QI))[(size_t)(R0 + j) * 512 + (C - 3072)] = f2h(v[j] * 0.125f);
        } else {
          if (C < 3648) {
            const int cc = C - 3584;
            float* of = smp ? p.out + O_KIS + (size_t)l * 32768 + (size_t)rs * 64 + cc : p.out + O_KIP + (size_t)l * 4194304 + (size_t)R0 * 64 + cc;
            u16* ob = smp ? ((u16*)(p.ws + WS_KIs)) + ((size_t)b * KIS_ROWS + 4096 + s0) * 64 + cc : ((u16*)(p.ws + WS_KIp)) + (size_t)R0 * 64 + cc;
#pragma unroll
            for (int j = 0; j < 4; ++j) { of[(size_t)j * 64] = v[j]; ob[(size_t)j * 64] = f2h(v[j]); }
          } else if (C < 3656) {
#pragma unroll
            for (int j = 0; j < 4; ++j) ((float*)(p.ws + WS_WI))[(size_t)(R0 + j) * 8 + (C - 3648)] = v[j] * 0.35355339059327373f;
          }
        }
      }
    }
  }
}

DI void ssm_unit(const Params& p, int l, int g, int row0, int T, float& hr, float& hi, bool write_y, u16* tile) {
  const int lane = tidx() & 63, fr = lane & 15, fq = lane >> 4;
  const int lg = l * 32 + g;
  const float abr = ((float*)(p.ws + WS_ab))[((size_t)lg * 64 + lane) * 2], abi = ((float*)(p.ws + WS_ab))[((size_t)lg * 64 + lane) * 2 + 1];
  const int ntile = T >> 4;
  bf16x8 am[8];
#pragma unroll
  for (int mt = 0; mt < 8; ++mt) am[mt] = fq < 2 ? ldg8(((u16*)(p.ws + WS_Bmat)) + ((size_t)lg * 128 + mt * 16 + fr) * 16 + fq * 8) : zero8();
  for (int nt = 0; nt < ntile; ++nt) {
    const bf16x8 bu = fq < 2 ? ldg8(((u16*)(p.ws + WS_U)) + (size_t)(row0 + nt * 16 + fr) * 512 + g * 16 + fq * 8) : zero8();
#pragma unroll
    for (int mt = 0; mt < 8; ++mt) {
      const f32x4 a = mfma16(am[mt], bu, f32x4{0.f, 0.f, 0.f, 0.f});
      uint2 o; o.x = pack2(a[0], a[1]); o.y = pack2(a[2], a[3]);
      *reinterpret_cast<uint2*>(tile + (nt * 16 + fr) * 136 + mt * 16 + fq * 4) = o;
    }
  }
  wave_lds_sync();
  for (int t = 0; t < T; ++t) {
    const float br = bf2f(tile[t * 136 + lane]), bi = bf2f(tile[t * 136 + 64 + lane]);
    const float nhr = fmaf(abr, hr, fmaf(-abi, hi, br));
    const float nhi = fmaf(abr, hi, fmaf(abi, hr, bi));
    hr = nhr; hi = nhi;
    if (write_y) { tile[t * 136 + lane] = f2bf(hr); tile[t * 136 + 64 + lane] = f2bf(hi); }
  }
  if (!write_y) return;
  wave_lds_sync();
  bf16x8 cm[4];
#pragma unroll
  for (int ks = 0; ks < 4; ++ks) cm[ks] = ldg8(((u16*)(p.ws + WS_Cmat)) + ((size_t)lg * 16 + fr) * 128 + ks * 32 + fq * 8);
  const float dsk = p.d_skip[(size_t)lg * 16 + fr];
  for (int mt = 0; mt < ntile; ++mt) {
    f32x4 a = {0.f, 0.f, 0.f, 0.f};
#pragma unroll
    for (int ks = 0; ks < 4; ++ks) a = mfma16(*reinterpret_cast<const bf16x8*>(tile + (mt * 16 + fr) * 136 + ks * 32 + fq * 8), cm[ks], a);
#pragma unroll
    for (int j = 0; j < 4; ++j) {
      u16* up = ((u16*)(p.ws + WS_U)) + (size_t)(row0 + mt * 16 + fq * 4 + j) * 512 + g * 16 + fr;
      const float y = a[j] + dsk * bf2f(*up);
      *up = f2bf(geluf_(y));
    }
  }
  wave_lds_sync();
}

__device__ void indexer_unit(const Params& p, bool smp, int b, int q0, int nkeys, char* lds) {
  const int tid = tidx(), lane = tid & 63, wave = tid >> 6, fr = lane & 15, fq = lane >> 4;
  constexpr int HROW = 1025;
  uint32_t* hist = reinterpret_cast<uint32_t*>(lds);
  u16* maskbuf = reinterpret_cast<u16*>(lds);
  uint32_t* s_pref = reinterpret_cast<uint32_t*>(lds + 16 * HROW * 4);
  uint32_t* s_need = s_pref + 16;
  uint32_t* s_cnt = s_need + 16;
  uint32_t* s_cn = s_cnt + 16;
  uint32_t* s_flag = s_cn + 16;
  uint32_t* s_cand = s_flag + 16;
  constexpr int CAP = 16;
  constexpr int MB = 520;
  const int Rq0 = smp ? NP + b * 32 + q0 : b * 8192 + q0;
  const u16* KI = smp ? ((u16*)(p.ws + WS_KIs)) + (size_t)b * KIS_ROWS * 64 : ((u16*)(p.ws + WS_KIp)) + (size_t)b * 8192 * 64;
  const int ntiles = nkeys >> 4;

  bf16x8 aq[8][2];
#pragma unroll
  for (int h = 0; h < 8; ++h)
#pragma unroll
    for (int ks = 0; ks < 2; ++ks) aq[h][ks] = ldg8(((u16*)(p.ws + WS_QI)) + (size_t)(Rq0 + fr) * 512 + h * 64 + ks * 32 + fq * 8);
  float w[8];
#pragma unroll
  for (int h = 0; h < 8; ++h) w[h] = ((float*)(p.ws + WS_WI))[(size_t)(Rq0 + fr) * 8 + h];

  bf16x8 nb0 = zero8(), nb1 = zero8();
  auto load_keys = [&](int kt) {
    const u16* kp = KI + (size_t)(kt * 16 + fr) * 64 + fq * 8;
    nb0 = ldg8(kp); nb1 = ldg8(kp + 32);
  };
  auto score_keys = [&](int kt, uint32_t (&key)[4]) {
    const bf16x8 b0 = nb0, b1 = nb1;
    if (kt + 4 < ntiles) load_keys(kt + 4);
    float sc[4] = {0.f, 0.f, 0.f, 0.f};
#pragma unroll
    for (int h = 0; h < 8; ++h) {
      f32x4 a = mfma16h(b0, aq[h][0], f32x4{0.f, 0.f, 0.f, 0.f});
      a = mfma16h(b1, aq[h][1], a);
#pragma unroll
      for (int j = 0; j < 4; ++j) sc[j] = fmaf(w[h], __builtin_amdgcn_fmed3f(a[j], 0.f, 3.0e38f), sc[j]);
    }
#pragma unroll
    for (int j = 0; j < 4; ++j) {
      const uint32_t uu = __float_as_uint(sc[j]);
      key[j] = (uu & 0x80000000u) ? ~uu : (uu | 0x80000000u);
    }
  };

  __syncthreads();
  if (tid < 16) { s_pref[tid] = 0u; s_need[tid] = 256u; s_cn[tid] = 0u; if (tid == 0) s_flag[0] = 0u; }
  if (nkeys > 256) {
#pragma unroll 1
    for (int pass = 0; pass < 3; ++pass) {
      if (pass == 2 && s_flag[0] == 0u) break;
      for (int i = tid; i < 16 * HROW / 4; i += 256) reinterpret_cast<uint4*>(hist)[i] = uint4{0u, 0u, 0u, 0u};
      __syncthreads();
      const uint32_t pref = s_pref[fr];
      const int mshift = pass == 0 ? 32 : (pass == 1 ? 21 : 10);
      const int bshift = pass == 0 ? 21 : (pass == 1 ? 10 : 0);
      const uint32_t bmask = pass == 2 ? 1023u : 2047u;
      if (wave < ntiles) load_keys(wave);
#pragma unroll 2
      for (int kt = wave; kt < ntiles; kt += 4) {
        uint32_t key[4];
        score_keys(kt, key);
#pragma unroll
        for (int j = 0; j < 4; ++j) {
          const bool match = pass == 0 ? true : ((key[j] >> mshift) == pref);
          if (match) {
            const uint32_t bin = (key[j] >> bshift) & bmask;
            atomicAdd(&hist[fr * HROW + (bin >> 1)], (bin & 1u) ? 0x10000u : 1u);
          }
        }
      }
      __syncthreads();
      {
        const int q = tid >> 4, part = tid & 15;
        const int nb = pass == 2 ? 1024 : 2048;
        const int per = nb >> 4;
        const uint32_t* hq = hist + q * HROW;
        uint32_t mysum = 0;
        for (int wd = (part * per) >> 1; wd < ((part + 1) * per) >> 1; ++wd) { const uint32_t x = hq[wd]; mysum += (x & 0xffffu) + (x >> 16); }
        uint32_t v = mysum;
#pragma unroll
        for (int d = 1; d < 16; d <<= 1) { const uint32_t t2 = __shfl_down(v, d, 16); if (part + d < 16) v += t2; }
        const uint32_t above = v - mysum;
        const uint32_t need = s_need[q];
        const uint32_t prefq = s_pref[q];
        __syncthreads();
        if (above < need && need <= above + mysum) {
          uint32_t c = above;
          for (int bin = (part + 1) * per - 1; bin >= part * per; --bin) {
            const uint32_t cnt = (hq[bin >> 1] >> ((bin & 1) * 16)) & 0xffffu;
            if (c + cnt >= need) {
              s_pref[q] = (prefq << (pass == 2 ? 10 : 11)) | (uint32_t)bin;
              s_need[q] = need - c;
              if (pass == 1) { s_cnt[q] = cnt; if (cnt > (uint32_t)CAP) s_flag[0] = 1u; }
              break;
            }
            c += cnt;
          }
        }
        __syncthreads();
      }
    }
  } else {
    __syncthreads();
  }
  const bool fast = (nkeys > 256) && (s_flag[0] == 0u);
  const uint32_t thr = s_pref[fr];
  __syncthreads();
  const int nw16 = smp ? 260 : ntiles;
  if (wave < ntiles) load_keys(wave);
#pragma unroll 2
  for (int kt = wave; kt < nw16; kt += 4) {
    uint32_t word = 0;
    if (kt < ntiles) {
      uint32_t key[4];
      score_keys(kt, key);
      if (fast) {
#pragma unroll
        for (int j = 0; j < 4; ++j) {
          const uint32_t k22 = key[j] >> 10;
          word |= (k22 > thr ? 1u : 0u) << (fq * 4 + j);
          if (k22 == thr) {
            const uint32_t ci = atomicAdd(&s_cn[fr], 1u);
            if (ci < (uint32_t)CAP) s_cand[fr * CAP + ci] = (key[j] & 1023u) | ((uint32_t)(kt * 16 + fq * 4 + j) << 10);
          }
        }
      } else {
#pragma unroll
        for (int j = 0; j < 4; ++j) word |= (key[j] >= thr ? 1u : 0u) << (fq * 4 + j);
      }
      word |= __shfl_xor(word, 16);
      word |= __shfl_xor(word, 32);
    }
    if (fq == 0) maskbuf[fr * MB + kt] = (u16)word;
  }
  __syncthreads();
  if (fast) {
    if (tid < 16) {
      const uint32_t n = s_cn[tid] < (uint32_t)CAP ? s_cn[tid] : (uint32_t)CAP, need = s_need[tid];
      for (uint32_t i = 0; i < n; ++i) {
        const uint32_t ci = s_cand[tid * CAP + i], vi = ci & 1023u;
        uint32_t greater = 0;
        for (uint32_t k = 0; k < n; ++k) greater += ((s_cand[tid * CAP + k] & 1023u) > vi) ? 1u : 0u;
        if (greater < need) {
          const uint32_t pos = ci >> 10;
          maskbuf[tid * MB + (pos >> 4)] |= (u16)(1u << (pos & 15u));
        }
      }
    }
    __syncthreads();
  }
  {
    const int n8 = nw16 >> 2;
    for (int i = tid; i < 16 * n8; i += 256) {
      const int q = i / n8, c = i % n8;
      const uint2 vv = *reinterpret_cast<const uint2*>(maskbuf + q * MB + c * 4);
      u16* dst = smp ? ((u16*)(p.ws + WS_masks)) + (size_t)(b * 32 + q0 + q) * MS_ROW : ((u16*)(p.ws + WS_maskp)) + (size_t)(b * 8192 + q0 + q) * 512;
      *reinterpret_cast<uint2*>(dst + c * 4) = vv;
    }
  }
}

__device__ void ssm_local_scan(const Params& p, int l, int b, int c, int g) {
  const int lane = tidx() & 63;
  const int lg = l * 32 + g;
  const float abr = ((float*)(p.ws + WS_ab))[((size_t)lg * 64 + lane) * 2], abi = ((float*)(p.ws + WS_ab))[((size_t)lg * 64 + lane) * 2 + 1];
  float bbr[16], bbi[16];
#pragma unroll
  for (int n = 0; n < 16; ++n) {
    bbr[n] = ((float*)(p.ws + WS_BbF))[(((size_t)lg * 2 + 0) * 16 + n) * 64 + lane];
    bbi[n] = ((float*)(p.ws + WS_BbF))[(((size_t)lg * 2 + 1) * 16 + n) * 64 + lane];
  }
  float hr = 0.f, hi = 0.f;
  const u16* up = ((u16*)(p.ws + WS_U)) + ((size_t)b * 8192 + (size_t)c * 64) * 512 + g * 16;
  u32x4 cur[8], nxt[8];
#pragma unroll
  for (int k = 0; k < 4; ++k) {
    cur[2 * k] = *reinterpret_cast<const u32x4*>(up + (size_t)k * 512);
    cur[2 * k + 1] = *reinterpret_cast<const u32x4*>(up + (size_t)k * 512 + 8);
  }
  for (int t4 = 0; t4 < 16; ++t4) {
    if (t4 + 1 < 16) {
#pragma unroll
      for (int k = 0; k < 4; ++k) {
        nxt[2 * k] = *reinterpret_cast<const u32x4*>(up + (size_t)((t4 + 1) * 4 + k) * 512);
        nxt[2 * k + 1] = *reinterpret_cast<const u32x4*>(up + (size_t)((t4 + 1) * 4 + k) * 512 + 8);
      }
    }
#pragma unroll
    for (int k = 0; k < 4; ++k) {
      float br = 0.f, bi = 0.f;
#pragma unroll
      for (int h2 = 0; h2 < 2; ++h2) {
        const u32x4 w = cur[2 * k + h2];
#pragma unroll
        for (int d = 0; d < 4; ++d) {
          const float x0 = __uint_as_float(w[d] << 16), x1 = __uint_as_float(w[d] & 0xffff0000u);
          const int n = h2 * 8 + d * 2;
          br = fmaf(bbr[n], x0, br); bi = fmaf(bbi[n], x0, bi);
          br = fmaf(bbr[n + 1], x1, br); bi = fmaf(bbi[n + 1], x1, bi);
        }
      }
      const float nhr = fmaf(abr, hr, fmaf(-abi, hi, br));
      const float nhi = fmaf(abr, hi, fmaf(abi, hr, bi));
      hr = nhr; hi = nhi;
    }
#pragma unroll
    for (int k = 0; k < 8; ++k) cur[k] = nxt[k];
  }
  const size_t o = ((size_t)(b * 128 + c) * 32 + g) * 64 + lane;
  ((float*)(p.ws + WS_SlocR))[o] = hr; ((float*)(p.ws + WS_SlocI))[o] = hi;
}

__device__ void phase_ssmA_indexer(const Params& p, int l, char* lds) {
  const int wave = tidx() >> 6;
  const int x = blockIdx.x & 7, j = blockIdx.x >> 3, nb = gridDim.x >> 3;
  if (blockIdx.x < 32) indexer_unit(p, true, blockIdx.x >> 1, (blockIdx.x & 1) * 16, 4128, lds);
  for (int tlo = j; tlo < 256; tlo += nb) {
    const int th = 511 - tlo;
    indexer_unit(p, false, x, th * 16, ((th >> 2) + 1) * 64, lds);
    indexer_unit(p, false, x, tlo * 16, ((tlo >> 2) + 1) * 64, lds);
  }
  for (int u = blockIdx.x; u < 8192; u += gridDim.x) {
    const int wu = u * 4 + wave;
    ssm_local_scan(p, l, wu >> 12, (wu >> 5) & 127, wu & 31);
  }
}

DI bf16x8 pack8_bf16(float a0, float a1, float a2, float a3, float a4, float a5, float a6, float a7) {
  u32x4 r;
  asm("v_cvt_pk_bf16_f32 %0, %4, %5\n\tv_cvt_pk_bf16_f32 %1, %6, %7\n\tv_cvt_pk_bf16_f32 %2, %8, %9\n\tv_cvt_pk_bf16_f32 %3, %10, %11\n\ts_nop 1"
      : "=&v"(r[0]), "=&v"(r[1]), "=&v"(r[2]), "=&v"(r[3])
      : "v"(a0), "v"(a1), "v"(a2), "v"(a3), "v"(a4), "v"(a5), "v"(a6), "v"(a7));
  return __builtin_bit_cast(bf16x8, r);
}

__device__ void attn_unit(const Params& p, bool smp, int b, int chunk, int h, char* lds) {
  constexpr int LR = 72;
  constexpr int STG = 128 * LR;
  const int tid = tidx(), lane = tid & 63, wave = tid >> 6, fr = lane & 15, fq = lane >> 4;
  u16* sbase = reinterpret_cast<u16*>(lds);
  const int nq = smp ? 32 : 64;
  const int nkeys = smp ? 4128 : 64 * (chunk + 1);
  const int ntile = (nkeys + 63) >> 6;
  const int Rq0 = smp ? NP + b * 32 : b * 8192 + chunk * 64;
  const u16* Kb = (smp ? ((u16*)(p.ws + WS_Ks)) + (size_t)b * KS_ROWS * 512 : ((u16*)(p.ws + WS_Kp)) + (size_t)b * 8192 * 512) + h * 64;
  const int Sv = smp ? KS_ROWS : 8192;
  const u16* Vb = smp ? ((u16*)(p.ws + WS_VTs)) + ((size_t)b * 512 + h * 64) * KS_ROWS : ((u16*)(p.ws + WS_VTp)) + ((size_t)b * 512 + h * 64) * 8192;
  const bool active = wave * 16 < nq;
  const int qrow = active ? wave * 16 : 0;
  bf16x8 aq[2];
#pragma unroll
  for (int ks = 0; ks < 2; ++ks) aq[ks] = ldg8(((u16*)(p.ws + WS_Q)) + (size_t)(Rq0 + qrow + fr) * 512 + h * 64 + ks * 32 + fq * 8);
  const u16* mrow = smp ? ((u16*)(p.ws + WS_masks)) + (size_t)(b * 32 + qrow + fr) * MS_ROW
                        : ((u16*)(p.ws + WS_maskp)) + (size_t)(b * 8192 + chunk * 64 + qrow + fr) * 512;
  const int srow = tid >> 3, sch = tid & 7;
  u32x4 rk[2], rv[2];
  u32x2 mk;
  auto gload = [&](int kt) {
#pragma unroll
    for (int i = 0; i < 2; ++i) {
      rk[i] = *reinterpret_cast<const u32x4*>(Kb + (size_t)(kt * 64 + srow + i * 32) * 512 + sch * 8);
      rv[i] = *reinterpret_cast<const u32x4*>(Vb + (size_t)(srow + i * 32) * Sv + kt * 64 + sch * 8);
    }
    mk = *reinterpret_cast<const u32x2*>(mrow + kt * 4);
  };
  auto lstore = [&](int buf) {
    u16* sK = sbase + buf * STG;
    u16* sV = sK + 64 * LR;
#pragma unroll
    for (int i = 0; i < 2; ++i) {
      *reinterpret_cast<u32x4*>(sK + (srow + i * 32) * LR + sch * 8) = rk[i];
      *reinterpret_cast<u32x4*>(sV + (srow + i * 32) * LR + sch * 8) = rv[i];
    }
  };
  f32x4 Ot[4];
#pragma unroll
  for (int n = 0; n < 4; ++n) Ot[n] = f32x4{0.f, 0.f, 0.f, 0.f};
  float mrun = -1e29f, lrun = 0.f;
  gload(0);
  __syncthreads();
  lstore(0);
  u32x2 mcur = mk;
  if (ntile > 1) gload(1);
  __syncthreads();
  for (int kt = 0; kt < ntile; ++kt) {
    const int cur = kt & 1;
    const u32x2 mthis = mcur;
    if (kt + 1 < ntile) { lstore(cur ^ 1); mcur = mk; }
    if (kt + 2 < ntile) gload(kt + 2);
    if (active) {
      const u16* sK = sbase + cur * STG;
      const u16* sV = sK + 64 * LR;
      f32x4 st[4];
#pragma unroll
      for (int n = 0; n < 4; ++n) {
        f32x4 a = {0.f, 0.f, 0.f, 0.f};
#pragma unroll
        for (int ks = 0; ks < 2; ++ks) a = mfma16(*reinterpret_cast<const bf16x8*>(sK + (n * 16 + fr) * LR + ks * 32 + fq * 8), aq[ks], a);
        st[n] = a;
      }
      float mx = -1e30f;
#pragma unroll
      for (int n = 0; n < 4; ++n) {
        const uint32_t nib = ((n < 2 ? mthis[0] : mthis[1]) >> ((n & 1) * 16 + fq * 4)) & 15u;
#pragma unroll
        for (int j = 0; j < 4; ++j) {
          st[n][j] = (nib & (1u << j)) ? st[n][j] : -1e30f;
          mx = fmaxf(mx, st[n][j]);
        }
      }
      mx = fmaxf(mx, __shfl_xor(mx, 16));
      mx = fmaxf(mx, __shfl_xor(mx, 32));
      const float mnew = fmaxf(mrun, mx);
      const float alpha = __builtin_amdgcn_exp2f(mrun - mnew);
      mrun = mnew;
      float ps = 0.f;
#pragma unroll
      for (int n = 0; n < 4; ++n)
#pragma unroll
        for (int j = 0; j < 4; ++j) { st[n][j] = __builtin_amdgcn_exp2f(st[n][j] - mnew); ps += st[n][j]; }
      lrun = lrun * alpha + ps;
#pragma unroll
      for (int n = 0; n < 4; ++n)
#pragma unroll
        for (int j = 0; j < 4; ++j) Ot[n][j] *= alpha;
#pragma unroll
      for (int ks = 0; ks < 2; ++ks) {
        const bf16x8 pb = pack8_bf16(st[2 * ks][0], st[2 * ks][1], st[2 * ks][2], st[2 * ks][3],
                                     st[2 * ks + 1][0], st[2 * ks + 1][1], st[2 * ks + 1][2], st[2 * ks + 1][3]);
#pragma unroll
        for (int dt = 0; dt < 4; ++dt) {
          const u16* vr = sV + (dt * 16 + fr) * LR + ks * 32 + fq * 4;
          const u32x2 v0 = *reinterpret_cast<const u32x2*>(vr), v1 = *reinterpret_cast<const u32x2*>(vr + 16);
          const u32x4 vv = {v0[0], v0[1], v1[0], v1[1]};
          Ot[dt] = mfma16(__builtin_bit_cast(bf16x8, vv), pb, Ot[dt]);
        }
      }
    }
    __syncthreads();
  }
  if (active) {
    float ls = lrun;
    ls += __shfl_xor(ls, 16); ls += __shfl_xor(ls, 32);
    const float inv = 1.f / ls;
    const size_t ro = (size_t)(Rq0 + qrow + fr) * 512 + h * 64;
#pragma unroll
    for (int dt = 0; dt < 4; ++dt) {
      const size_t o = ro + dt * 16 + fq * 4;
      const u32x2 zz = *reinterpret_cast<const u32x2*>(((u16*)(p.ws + WS_ZA)) + o);
      const float z0 = __uint_as_float(zz[0] << 16), z1 = __uint_as_float(zz[0] & 0xffff0000u);
      const float z2 = __uint_as_float(zz[1] << 16), z3 = __uint_as_float(zz[1] & 0xffff0000u);
      u32x2 ov;
      ov[0] = pack2(Ot[dt][0] * inv * z0, Ot[dt][1] * inv * z1);
      ov[1] = pack2(Ot[dt][2] * inv * z2, Ot[dt][3] * inv * z3);
      *reinterpret_cast<u32x2*>(((u16*)(p.ws + WS_Q)) + o) = ov;
    }
  }
}

__device__ void phase_ssmB_attn(const Params& p, int l, char* lds) {
  const int x = blockIdx.x & 7, j = blockIdx.x >> 3, nb = gridDim.x >> 3;
  if (blockIdx.x >= gridDim.x - 64) {
    const int t = (gridDim.x - 1 - blockIdx.x) * 256 + tidx();
    const int pp = t & 63, g = (t >> 6) & 31, b = t >> 11;
    float ar = ((float*)(p.ws + WS_ab))[((size_t)(l * 32 + g) * 64 + pp) * 2], ai = ((float*)(p.ws + WS_ab))[((size_t)(l * 32 + g) * 64 + pp) * 2 + 1];
#pragma unroll
    for (int i = 0; i < 6; ++i) { const float nr = ar * ar - ai * ai, ni = 2.f * ar * ai; ar = nr; ai = ni; }
    float hr = 0.f, hi = 0.f;
    for (int c8 = 0; c8 < 128; c8 += 8) {
      float sr[8], si[8];
#pragma unroll
      for (int k = 0; k < 8; ++k) {
        const size_t o = ((size_t)(b * 128 + c8 + k) * 32 + g) * 64 + pp;
        sr[k] = ((float*)(p.ws + WS_SlocR))[o]; si[k] = ((float*)(p.ws + WS_SlocI))[o];
      }
#pragma unroll
      for (int k = 0; k < 8; ++k) {
        const size_t o = ((size_t)(b * 128 + c8 + k) * 32 + g) * 64 + pp;
        ((float*)(p.ws + WS_HstR))[o] = hr; ((float*)(p.ws + WS_HstI))[o] = hi;
        const float nhr = ar * hr - ai * hi + sr[k], nhi = ar * hi + ai * hr + si[k];
        hr = nhr; hi = nhi;
      }
    }
    p.out[O_SRP + (size_t)l * 16384 + (size_t)(b * 32 + g) * 64 + pp] = hr;
    p.out[O_SIP + (size_t)l * 16384 + (size_t)(b * 32 + g) * 64 + pp] = hi;
  }
  if (blockIdx.x < 128) attn_unit(p, true, blockIdx.x >> 3, 0, blockIdx.x & 7, lds);
  for (int pi = 0; pi < 8; ++pi) {
    const int pair = x + 8 * pi, b = pair >> 3, h = pair & 7;
    for (int c = j; c < 64; c += nb) {
      attn_unit(p, false, b, 127 - c, h, lds);
      attn_unit(p, false, b, c, h, lds);
    }
  }
}

__device__ void phase_ssmC(const Params& p, int l, char* lds) {
  const int wave = tidx() >> 6, lane = tidx() & 63;
  const int NU = (32768 + 512) / 4;
  for (int u = blockIdx.x; u < NU; u += gridDim.x) {
    const int wu = u * 4 + wave;
    u16* tile = reinterpret_cast<u16*>(lds) + wave * (64 * 136);
    if (wu < 32768) {
      const int g = wu & 31, c = (wu >> 5) & 127, b = wu >> 12;
      const size_t o = ((size_t)(b * 128 + c) * 32 + g) * 64 + lane;
      float hr = ((float*)(p.ws + WS_HstR))[o], hi = ((float*)(p.ws + WS_HstI))[o];
      ssm_unit(p, l, g, b * 8192 + c * 64, 64, hr, hi, true, tile);
    } else {
      const int i = wu - 32768;
      const int g = i & 31, b = i >> 5;
      const size_t si = ((size_t)(l * 16 + b) * 32 + g) * 64 + lane;
      float hr = p.st_re[si], hi = p.st_im[si];
      ssm_unit(p, l, g, NP + b * 32, 32, hr, hi, true, tile);
      p.out[O_SRS + si] = hr;
      p.out[O_SIS + si] = hi;
    }
  }
}

__device__ void phase_glu(const Params& p, int l, char* lds) {
  const int lane = tidx() & 63, wave = tidx() >> 6, wr = wave >> 1, wc = wave & 1, fr = lane & 15, fq = lane >> 4;
  GemmOrder ord; ord.init(NTOK / 128, 4);
  int mt, nt;
  while (ord.next(mt, nt)) {
    f32x4 acc[4][4];
    zero_acc<4>(acc);
    gemm_accum<4>(acc, ((u16*)(p.ws + WS_U)) + (size_t)mt * 128 * 512, 512, ((u16*)(p.ws + WS_WgluT)) + ((size_t)l * 512 + nt * 128) * 512, 512, 512, reinterpret_cast<u16*>(lds));
#pragma unroll
    for (int m = 0; m < 4; ++m)
#pragma unroll
      for (int n = 0; n < 4; ++n) {
        const int C = nt * 128 + wc * 64 + n * 16 + fr;
        const float bg = p.b_glu[l * 512 + C];
#pragma unroll
        for (int j = 0; j < 4; ++j) {
          const size_t o = (size_t)(mt * 128 + wr * 64 + m * 16 + fq * 4 + j) * 512 + C;
          const float yg = bf2f(((u16*)(p.ws + WS_U))[o]);
          ((u16*)(p.ws + WS_ZS))[o] = f2bf(yg * sigmoidf_(acc[m][n][j] + bg) * bf2f(((u16*)(p.ws + WS_ZS))[o]));
        }
      }
  }
}

__device__ void phase_merge(const Params& p, int l, char* lds) {
  const int lane = tidx() & 63, wave = tidx() >> 6, wr = wave >> 1, wc = wave & 1, fr = lane & 15, fq = lane >> 4;
  u16* L = reinterpret_cast<u16*>(lds);
  GemmOrder ord; ord.init(NTOK / 128, 16);
  int mt, nt;
  while (ord.next(mt, nt)) {
    f32x4 acc[4][2], res[4][2];
    zero_acc<2>(acc);
    gemm_accum<2, true>(acc, ((u16*)(p.ws + WS_H)) + (size_t)mt * 128 * 1024, 1024, ((u16*)(p.ws + WS_WgT)) + ((size_t)l * 2048 + nt * 64) * 1024, 1024, 1024, L);
#pragma unroll
    for (int m = 0; m < 4; ++m)
#pragma unroll
      for (int n = 0; n < 2; ++n)
#pragma unroll
        for (int j = 0; j < 4; ++j) res[m][n][j] = sigmoidf_(acc[m][n][j]);
    zero_acc<2>(acc);
    gemm_accum<2>(acc, ((u16*)(p.ws + WS_ZS)) + (size_t)mt * 128 * 512, 512, ((u16*)(p.ws + WS_WpsT)) + ((size_t)l * 1024 + nt * 64) * 512, 512, 512, L);
#pragma unroll
    for (int m = 0; m < 4; ++m)
#pragma unroll
      for (int n = 0; n < 2; ++n)
#pragma unroll
        for (int j = 0; j < 4; ++j) res[m][n][j] *= acc[m][n][j];
    f32x4 gt[4][2];
    zero_acc<2>(gt);
    gemm_accum<2, true>(gt, ((u16*)(p.ws + WS_H)) + (size_t)mt * 128 * 1024, 1024, ((u16*)(p.ws + WS_WgT)) + ((size_t)l * 2048 + 1024 + nt * 64) * 1024, 1024, 1024, L);
    zero_acc<2>(acc);
    gemm_accum<2>(acc, ((u16*)(p.ws + WS_Q)) + (size_t)mt * 128 * 512, 512, ((u16*)(p.ws + WS_WpaT)) + ((size_t)l * 1024 + nt * 64) * 512, 512, 512, L);
#pragma unroll
    for (int m = 0; m < 4; ++m)
#pragma unroll
      for (int n = 0; n < 2; ++n) {
        const int C = nt * 64 + wc * 32 + n * 16 + fr;
#pragma unroll
        for (int j = 0; j < 4; ++j) {
          const float v = res[m][n][j] + sigmoidf_(gt[m][n][j]) * acc[m][n][j];
          ((u16*)(p.ws + WS_U))[(size_t)(mt * 128 + wr * 64 + m * 16 + fq * 4 + j) * 1024 + C] = f2bf(v);
        }
      }
  }
}

__device__ void phase_out(const Params& p, int l, char* lds) {
  const int lane = tidx() & 63, wave = tidx() >> 6, wr = wave >> 1, wc = wave & 1, fr = lane & 15, fq = lane >> 4;
  GemmOrder ord; ord.init(NTOK / 128, 8);
  int mt, nt;
  while (ord.next(mt, nt)) {
    f32x4 acc[4][4];
    zero_acc<4>(acc);
    gemm_accum<4>(acc, ((u16*)(p.ws + WS_U)) + (size_t)mt * 128 * 1024, 1024, ((u16*)(p.ws + WS_WoT)) + ((size_t)l * 1024 + nt * 128) * 1024, 1024, 1024, reinterpret_cast<u16*>(lds));
#pragma unroll
    for (int m = 0; m < 4; ++m) {
      const int R0 = mt * 128 + wr * 64 + m * 16 + fq * 4;
      const float* gate = ((float*)(p.ws + WS_mod)) + ((size_t)l * 24 + batch_of(R0)) * 3072 + 2048;
#pragma unroll
      for (int n = 0; n < 4; ++n) {
        const int C = nt * 128 + wc * 64 + n * 16 + fr;
        const float gv = gate[C];
#pragma unroll
        for (int j = 0; j < 4; ++j) {
          const float xo = xin_row(p, l, R0 + j)[C];
          p.out[(size_t)(R0 + j) * 1024 + C] = xo + gv * acc[m][n][j];
        }
      }
    }
  }
}

__device__ void phase_final(const Params& p) {
  const int wave = tidx() >> 6, lane = tidx() & 63;
  const int gw = blockIdx.x * 4 + wave, nw = gridDim.x * 4;
  for (int R = gw; R < NTOK; R += nw) {
    float* x = p.out + (size_t)R * 1024;
    float4 v[4];
    float ss = 0.f;
#pragma unroll
    for (int i = 0; i < 4; ++i) {
      v[i] = *reinterpret_cast<const float4*>(x + i * 256 + lane * 4);
      ss += v[i].x * v[i].x + v[i].y * v[i].y + v[i].z * v[i].z + v[i].w * v[i].w;
    }
    ss = wave_sum(ss);
    const float rstd = rsqrtf(ss * (1.f / 1024.f) + 1e-6f);
#pragma unroll
    for (int i = 0; i < 4; ++i) {
      const int c = i * 256 + lane * 4;
      const float4 g4 = *reinterpret_cast<const float4*>(p.g_final + c);
      float4 o;
      o.x = v[i].x * rstd * g4.x; o.y = v[i].y * rstd * g4.y; o.z = v[i].z * rstd * g4.z; o.w = v[i].w * rstd * g4.w;
      *reinterpret_cast<float4*>(x + c) = o;
    }
  }
}

__global__ void __launch_bounds__(256, 2) fwd_megakernel(Params p) {
  extern __shared__ __attribute__((aligned(16))) char lds[];
  cg::grid_group grid = cg::this_grid();
  for (int ph = p.phase_lo; ph <= p.phase_hi; ++ph) {
    if (ph > p.phase_lo) grid.sync();
    Params q = p;
#define LAUNDER(f) asm volatile("" : "+s"(q.f))
    LAUNDER(x_prompt); LAUNDER(x_sample); LAUNDER(cache_k); LAUNDER(cache_v); LAUNDER(cache_kidx); LAUNDER(st_re); LAUNDER(st_im);
    LAUNDER(c_prompt); LAUNDER(c_sample); LAUNDER(w_mod); LAUNDER(b_mod); LAUNDER(g_norm); LAUNDER(w_in); LAUNDER(a_re); LAUNDER(a_im);
    LAUNDER(log_dt); LAUNDER(b_re); LAUNDER(b_im); LAUNDER(c_re); LAUNDER(c_im); LAUNDER(d_skip); LAUNDER(w_glu); LAUNDER(b_glu);
    LAUNDER(w_ps); LAUNDER(w_pa); LAUNDER(w_o); LAUNDER(g_final); LAUNDER(out); LAUNDER(ws);
#undef LAUNDER
    if (ph == 0) phase_prep(q, lds);
    else if (ph == NPHASE - 1) phase_final(q);
    else {
      const int l = (ph - 1) >> 3, s = (ph - 1) & 7;
      switch (s) {
        case 0: phase_norm(q, l); break;
        case 1: phase_inproj(q, l, lds); break;
        case 2: phase_ssmA_indexer(q, l, lds); break;
        case 3: phase_ssmB_attn(q, l, lds); break;
        case 4: phase_ssmC(q, l, lds); break;
        case 5: phase_glu(q, l, lds); break;
        case 6: phase_merge(q, l, lds); break;
        default: phase_out(q, l, lds); break;
      }
    }
  }
}

extern "C" void kernel_launch(void* const* d_in, const int* in_sizes, int n_in, void* d_out, int out_size, void* d_ws, size_t ws_size,
                              hipStream_t stream) {
  static int grid_blocks = 0;
  if (!grid_blocks) {
    int dev = 0, cus = 0, per_cu = 0;
    hipGetDevice(&dev);
    hipDeviceGetAttribute(&cus, hipDeviceAttributeMultiprocessorCount, dev);
    hipFuncSetAttribute((const void*)fwd_megakernel, hipFuncAttributeMaxDynamicSharedMemorySize, LDS_BYTES);
    hipOccupancyMaxActiveBlocksPerMultiprocessor(&per_cu, (const void*)fwd_megakernel, 256, LDS_BYTES);
    if (per_cu < 1) per_cu = 1;
    if (per_cu > 2) per_cu = 2;
    grid_blocks = cus * per_cu;
  }
  Params p{};
  const float* const* in = reinterpret_cast<const float* const*>(d_in);
  p.x_prompt = in[0]; p.x_sample = in[1]; p.cache_k = in[2]; p.cache_v = in[3]; p.cache_kidx = in[4];
  p.st_re = in[5]; p.st_im = in[6]; p.c_prompt = in[7]; p.c_sample = in[8];
  p.w_mod = in[9]; p.b_mod = in[10]; p.g_norm = in[11]; p.w_in = in[12]; p.a_re = in[13]; p.a_im = in[14]; p.log_dt = in[15];
  p.b_re = in[16]; p.b_im = in[17]; p.c_re = in[18]; p.c_im = in[19]; p.d_skip = in[20];
  p.w_glu = in[21]; p.b_glu = in[22]; p.w_ps = in[23]; p.w_pa = in[24]; p.w_o = in[25]; p.g_final = in[26];
  p.out = (float*)d_out;
  p.ws = (char*)d_ws;
  if (WS_TOTAL > ws_size) fprintf(stderr, "kernel_launch: workspace too small: need %zu have %zu\n", (size_t)WS_TOTAL, ws_size);
#if MULTI_LAUNCH
  for (int ph = 0; ph < NPHASE; ++ph) {
    p.phase_lo = ph; p.phase_hi = ph;
    hipLaunchKernelGGL(fwd_megakernel, dim3(grid_blocks), dim3(256), LDS_BYTES, stream, p);
  }
#else
  p.phase_lo = 0; p.phase_hi = NPHASE - 1;
  void* args[] = {&p};
  hipError_t e = hipLaunchCooperativeKernel((void*)fwd_megakernel, dim3(grid_blocks), dim3(256), args, LDS_BYTES, stream);
  if (e != hipSuccess) fprintf(stderr, "cooperative launch failed: %s (grid %d)\n", hipGetErrorString(e), grid_blocks);
#endif
}
```

```cpp
#include <hip/hip_runtime.h>
#include <hip/hip_cooperative_groups.h>
#include <stdint.h>
#include <stdio.h>
namespace cg = cooperative_groups;

#ifndef MULTI_LAUNCH
#define MULTI_LAUNCH 0
#endif

#define DI __device__ __forceinline__
typedef __attribute__((ext_vector_type(8))) short bf16x8;
typedef __attribute__((ext_vector_type(4))) float f32x4;
typedef unsigned short u16;
typedef __attribute__((ext_vector_type(4))) unsigned u32x4;
typedef __attribute__((ext_vector_type(2))) unsigned u32x2;

constexpr int NP = 65536, NS = 512, NTOK = NP + NS;
constexpr int D_IN = 5704, N_IN1 = 3656, N_IN1P = 3712;
constexpr int KS_ROWS = 4160, KIS_ROWS = 4128, MS_ROW = 264;
constexpr int LDS_BYTES = 73728;
constexpr int NPHASE = 18;

constexpr size_t O_KP = 67633152, O_VP = 134742016, O_KIP = 201850880, O_SRP = 210239488, O_SIP = 210272256,
                 O_KS = 210305024, O_VS = 210829312, O_KIS = 211353600, O_SRS = 211419136, O_SIS = 211484672;

struct Params {
  const float *x_prompt, *x_sample, *cache_k, *cache_v, *cache_kidx, *st_re, *st_im, *c_prompt, *c_sample;
  const float *w_mod, *b_mod, *g_norm, *w_in, *a_re, *a_im, *log_dt, *b_re, *b_im, *c_re, *c_im, *d_skip;
  const float *w_glu, *b_glu, *w_ps, *w_pa, *w_o, *g_final;
  float* out;
  char* ws;
  int phase_lo, phase_hi;
};
constexpr size_t al256(size_t x) { return (x + 255) & ~(size_t)255; }
constexpr size_t WS_WinT = 0;
constexpr size_t WS_WgT = WS_WinT + al256((size_t)2 * N_IN1P * 1024 * 2);
constexpr size_t WS_WgluT = WS_WgT + al256((size_t)2 * 2048 * 1024 * 2);
constexpr size_t WS_WpsT = WS_WgluT + al256((size_t)2 * 512 * 512 * 2);
constexpr size_t WS_WpaT = WS_WpsT + al256((size_t)2 * 1024 * 512 * 2);
constexpr size_t WS_WoT = WS_WpaT + al256((size_t)2 * 1024 * 512 * 2);
constexpr size_t WS_mod = WS_WoT + al256((size_t)2 * 1024 * 1024 * 2);
constexpr size_t WS_ab = WS_mod + al256((size_t)2 * 24 * 3072 * 4);
constexpr size_t WS_Bmat = WS_ab + al256((size_t)2 * 32 * 64 * 2 * 4);
constexpr size_t WS_Cmat = WS_Bmat + al256((size_t)2 * 32 * 128 * 16 * 2);
constexpr size_t WS_H = WS_Cmat + al256((size_t)2 * 32 * 16 * 128 * 2);
constexpr size_t WS_U = WS_H + al256((size_t)NTOK * 1024 * 2);
constexpr size_t WS_QI = WS_U + (size_t)NTOK * 512 * 2;
constexpr size_t WS_ZS = WS_QI + al256((size_t)NTOK * 512 * 2);
constexpr size_t WS_Q = WS_ZS + al256((size_t)NTOK * 512 * 2);
constexpr size_t WS_ZA = WS_Q + al256((size_t)NTOK * 512 * 2);
constexpr size_t WS_Kp = WS_ZA + al256((size_t)NTOK * 512 * 2);
constexpr size_t WS_VTp = WS_Kp + al256((size_t)NP * 512 * 2);
constexpr size_t WS_KIp = WS_VTp + al256((size_t)NP * 512 * 2);
constexpr size_t WS_Ks = WS_KIp + al256((size_t)NP * 64 * 2);
constexpr size_t WS_VTs = WS_Ks + al256((size_t)16 * KS_ROWS * 512 * 2);
constexpr size_t WS_KIs = WS_VTs + al256((size_t)16 * 512 * KS_ROWS * 2);
constexpr size_t WS_WI = WS_KIs + al256((size_t)16 * KIS_ROWS * 64 * 2);
constexpr size_t WS_SlocR = WS_WI + al256((size_t)NTOK * 8 * 4);
constexpr size_t WS_SlocI = WS_SlocR + al256((size_t)8 * 128 * 32 * 64 * 4);
constexpr size_t WS_HstR = WS_SlocI + al256((size_t)8 * 128 * 32 * 64 * 4);
constexpr size_t WS_HstI = WS_HstR + al256((size_t)8 * 128 * 32 * 64 * 4);
constexpr size_t WS_maskp = WS_HstI + al256((size_t)8 * 128 * 32 * 64 * 4);
constexpr size_t WS_masks = WS_maskp + al256((size_t)NP * 512 * 2);
constexpr size_t WS_BbF = WS_masks + al256((size_t)NS * MS_ROW * 2);
constexpr size_t WS_TOTAL = WS_BbF + al256((size_t)64 * 2 * 16 * 64 * 4);

DI u16 f2bf(float x) { uint32_t u = __float_as_uint(x); u += 0x7fffu + ((u >> 16) & 1u); return (u16)(u >> 16); }
DI float bf2f(u16 h) { return __uint_as_float(((uint32_t)h) << 16); }
DI uint32_t pack2(float a, float b) { return (uint32_t)f2bf(a) | ((uint32_t)f2bf(b) << 16); }
DI float sigmoidf_(float x) { return 1.f / (1.f + __expf(-x)); }
DI float siluf_(float x) { return x * sigmoidf_(x); }
DI float geluf_(float v) { return v * sigmoidf_(1.5957691216f * (v + 0.044715f * v * v * v)); }
DI float wave_sum(float v) {
#pragma unroll
  for (int o = 32; o > 0; o >>= 1) v += __shfl_xor(v, o);
  return v;
}
DI int tidx() { int t = threadIdx.x; asm volatile("" : "+v"(t)); return t; }
DI void wave_lds_sync() { asm volatile("s_waitcnt lgkmcnt(0)" ::: "memory"); }
DI f32x4 mfma16(bf16x8 a, bf16x8 b, f32x4 c) { return __builtin_amdgcn_mfma_f32_16x16x32_bf16(a, b, c, 0, 0, 0); }
typedef _Float16 f16x8 __attribute__((ext_vector_type(8)));
DI f32x4 mfma16h(bf16x8 a, bf16x8 b, f32x4 c) { return __builtin_amdgcn_mfma_f32_16x16x32_f16(__builtin_bit_cast(f16x8, a), __builtin_bit_cast(f16x8, b), c, 0, 0, 0); }
DI u16 f2h(float x) { const _Float16 h = (_Float16)x; return __builtin_bit_cast(u16, h); }
DI uint32_t pack2h(float a, float b) { return (uint32_t)f2h(a) | ((uint32_t)f2h(b) << 16); }
DI bf16x8 ldg8(const u16* p) { return *reinterpret_cast<const bf16x8*>(p); }
DI bf16x8 zero8() { bf16x8 z = {0, 0, 0, 0, 0, 0, 0, 0}; return z; }

DI const float* xin_row(const Params& p, int l, int R) {
  if (l == 0) return R < NP ? p.x_prompt + (size_t)R * 1024 : p.x_sample + (size_t)(R - NP) * 1024;
  return p.out + (size_t)R * 1024;
}
DI int batch_of(int R) { return R < NP ? (R >> 13) : 8 + ((R - NP) >> 5); }

template <int NT, bool F16 = false>
DI void gemm_accum(f32x4 (&acc)[4][NT], const u16* __restrict__ A, int lda, const u16* __restrict__ Bt, int ldb, int K, u16* lds) {
  constexpr int LR = 72;
  constexpr int BN = 32 * NT;
  constexpr int NBCH = BN / 32;
  constexpr int BUF = 256 * LR;
  const int tid = tidx(), lane = tid & 63, wave = tid >> 6, wr = wave >> 1, wc = wave & 1, fr = lane & 15, fq = lane >> 4;
  u32x4 ra[4], rb[NBCH];
  const int crow = tid >> 3, cch = tid & 7;
  const u16* Ap = A + (size_t)crow * lda + cch * 8;
  const u16* Bp = Bt + (size_t)crow * ldb + cch * 8;
  const int nk = K >> 6;
  auto gload = [&](int kt) {
    const int k0 = kt << 6;
#pragma unroll
    for (int i = 0; i < 4; ++i) ra[i] = *reinterpret_cast<const u32x4*>(Ap + (size_t)(i * 32) * lda + k0);
#pragma unroll
    for (int i = 0; i < NBCH; ++i) rb[i] = *reinterpret_cast<const u32x4*>(Bp + (size_t)(i * 32) * ldb + k0);
  };
  auto lstore = [&](int buf) {
    u16* sA = lds + buf * BUF;
    u16* sB = sA + 128 * LR;
#pragma unroll
    for (int i = 0; i < 4; ++i) *reinterpret_cast<u32x4*>(sA + (crow + i * 32) * LR + cch * 8) = ra[i];
#pragma unroll
    for (int i = 0; i < NBCH; ++i) *reinterpret_cast<u32x4*>(sB + (crow + i * 32) * LR + cch * 8) = rb[i];
  };
  gload(0);
  __syncthreads();
  lstore(0);
  if (nk > 1) gload(1);
  __syncthreads();
  for (int kt = 0; kt < nk; ++kt) {
    const int cur = kt & 1;
    if (kt + 1 < nk) lstore(cur ^ 1);
    if (kt + 2 < nk) gload(kt + 2);
    const u16* sA = lds + cur * BUF;
    const u16* sB = sA + 128 * LR;
#pragma unroll
    for (int ks = 0; ks < 2; ++ks) {
      bf16x8 a[4], b[NT];
#pragma unroll
      for (int m = 0; m < 4; ++m) a[m] = *reinterpret_cast<const bf16x8*>(sA + (wr * 64 + m * 16 + fr) * LR + ks * 32 + fq * 8);
#pragma unroll
      for (int n = 0; n < NT; ++n) b[n] = *reinterpret_cast<const bf16x8*>(sB + (wc * 16 * NT + n * 16 + fr) * LR + ks * 32 + fq * 8);
#pragma unroll
      for (int m = 0; m < 4; ++m)
#pragma unroll
        for (int n = 0; n < NT; ++n) acc[m][n] = F16 ? mfma16h(a[m], b[n], acc[m][n]) : mfma16(a[m], b[n], acc[m][n]);
    }
    __syncthreads();
  }
}
template <int NT>
DI void zero_acc(f32x4 (&acc)[4][NT]) {
#pragma unroll
  for (int m = 0; m < 4; ++m)
#pragma unroll
    for (int n = 0; n < NT; ++n) acc[m][n] = f32x4{0.f, 0.f, 0.f, 0.f};
}


struct GemmOrder {
  int x, j, nb, cnt, NN, k;
  DI void init(int nM, int NN_) { x = blockIdx.x & 7; j = blockIdx.x >> 3; nb = gridDim.x >> 3; cnt = (nM - x + 7) >> 3; NN = NN_; k = 0; }
  DI bool next(int& mt, int& nt) {
    for (;;) {
      const int s = j + nb * k; ++k;
      const int g = s / (4 * NN), r = s - g * (4 * NN);
      if (g * 4 >= cnt) return false;
      const int i = g * 4 + (r & 3);
      if (i >= cnt) continue;
      mt = x + 8 * i; nt = r >> 2; return true;
    }
  }
};
template <bool F16>
DI void transpose_w(const float* __restrict__ W, int K, int N, int n0, int ncount, u16* __restrict__ WT, int gtid, int gstride) {
  const int total = ncount * (K >> 3);
  for (int idx = gtid; idx < total; idx += gstride) {
    const int n = idx % ncount, kb = idx / ncount;
    const float* src = W + (size_t)(kb * 8) * N + n0 + n;
    float f[8];
#pragma unroll
    for (int j = 0; j < 8; ++j) f[j] = src[(size_t)j * N];
    uint4 o;
    if (F16) { o.x = pack2h(f[0], f[1]); o.y = pack2h(f[2], f[3]); o.z = pack2h(f[4], f[5]); o.w = pack2h(f[6], f[7]); }
    else { o.x = pack2(f[0], f[1]); o.y = pack2(f[2], f[3]); o.z = pack2(f[4], f[5]); o.w = pack2(f[6], f[7]); }
    *reinterpret_cast<uint4*>(WT + (size_t)n * K + kb * 8) = o;
  }
}

__device__ void phase_prep(const Params& p, char* lds) {
  const int gtid = blockIdx.x * 256 + tidx(), gstride = gridDim.x * 256;
  for (int l = 0; l < 2; ++l) {
    transpose_w<true>(p.w_in + (size_t)l * 1024 * D_IN, 1024, D_IN, 0, N_IN1, ((u16*)(p.ws + WS_WinT)) + (size_t)l * N_IN1P * 1024, gtid, gstride);
    transpose_w<true>(p.w_in + (size_t)l * 1024 * D_IN, 1024, D_IN, N_IN1, 2048, ((u16*)(p.ws + WS_WgT)) + (size_t)l * 2048 * 1024, gtid, gstride);
    transpose_w<false>(p.w_glu + (size_t)l * 512 * 512, 512, 512, 0, 512, ((u16*)(p.ws + WS_WgluT)) + (size_t)l * 512 * 512, gtid, gstride);
    transpose_w<false>(p.w_ps + (size_t)l * 512 * 1024, 512, 1024, 0, 1024, ((u16*)(p.ws + WS_WpsT)) + (size_t)l * 1024 * 512, gtid, gstride);
    transpose_w<false>(p.w_pa + (size_t)l * 512 * 1024, 512, 1024, 0, 1024, ((u16*)(p.ws + WS_WpaT)) + (size_t)l * 1024 * 512, gtid, gstride);
    transpose_w<false>(p.w_o + (size_t)l * 1024 * 1024, 1024, 1024, 0, 1024, ((u16*)(p.ws + WS_WoT)) + (size_t)l * 1024 * 1024, gtid, gstride);
  }
  for (int idx = gtid; idx < 2 * 32 * 64; idx += gstride) {
    const int lg = idx >> 6, pp = idx & 63;
    const float are = p.a_re[idx], aim = p.a_im[idx];
    const float dt = expf(p.log_dt[lg]);
    const float mag = expf(are * dt), ang = aim * dt;
    const float kk = rintf(ang * 0.15915494309189535f);
    float r = fmaf(-kk, 6.2831854820251465f, ang);
    r = fmaf(-kk, -1.7484556e-07f, r);
    const float cs = cosf(r), sn = sinf(r);
    const float abr = mag * cs, abi = mag * sn;
    const float den = are * are + aim * aim;
    const float nr = abr - 1.f, ni = abi;
    const float fre = (nr * are + ni * aim) / den, fim = (ni * are - nr * aim) / den;
    ((float*)(p.ws + WS_ab))[idx * 2] = abr; ((float*)(p.ws + WS_ab))[idx * 2 + 1] = abi;
#pragma unroll
    for (int n = 0; n < 16; ++n) {
      const float br = p.b_re[(size_t)idx * 16 + n], bi = p.b_im[(size_t)idx * 16 + n];
      ((float*)(p.ws + WS_BbF))[(((size_t)lg * 2 + 0) * 16 + n) * 64 + pp] = fre * br - fim * bi;
      ((float*)(p.ws + WS_BbF))[(((size_t)lg * 2 + 1) * 16 + n) * 64 + pp] = fre * bi + fim * br;
      ((u16*)(p.ws + WS_Bmat))[((size_t)lg * 128 + pp) * 16 + n] = f2bf(fre * br - fim * bi);
      ((u16*)(p.ws + WS_Bmat))[((size_t)lg * 128 + 64 + pp) * 16 + n] = f2bf(fre * bi + fim * br);
      ((u16*)(p.ws + WS_Cmat))[((size_t)lg * 16 + n) * 128 + pp] = f2bf(p.c_re[((size_t)lg * 16 + n) * 64 + pp]);
      ((u16*)(p.ws + WS_Cmat))[((size_t)lg * 16 + n) * 128 + 64 + pp] = f2bf(-p.c_im[((size_t)lg * 16 + n) * 64 + pp]);
    }
  }
  float* red = reinterpret_cast<float*>(lds);
  for (int u = blockIdx.x; u < 192; u += gridDim.x) {
    const int l = u / 96, cg_ = u % 96;
    const int col = tidx() & 31, ks = tidx() >> 5;
    float acc[24];
#pragma unroll
    for (int r = 0; r < 24; ++r) acc[r] = 0.f;
    const float* wm = p.w_mod + (size_t)l * 1024 * 3072 + cg_ * 32 + col;
    for (int k = ks * 128; k < ks * 128 + 128; ++k) {
      const float w = wm[(size_t)k * 3072];
#pragma unroll
      for (int r = 0; r < 24; ++r) {
        const float c = r < 8 ? p.c_prompt[r * 1024 + k] : p.c_sample[(r - 8) * 1024 + k];
        acc[r] = fmaf(siluf_(c), w, acc[r]);
      }
    }
    __syncthreads();
#pragma unroll
    for (int r = 0; r < 24; ++r) red[(ks * 24 + r) * 32 + col] = acc[r];
    __syncthreads();
    for (int o = tidx(); o < 768; o += 256) {
      const int r = o >> 5, c = o & 31;
      float s = p.b_mod[l * 3072 + cg_ * 32 + c];
#pragma unroll
      for (int k8 = 0; k8 < 8; ++k8) s += red[(k8 * 24 + r) * 32 + c];
      ((float*)(p.ws + WS_mod))[((size_t)l * 24 + r) * 3072 + cg_ * 32 + c] = s;
    }
  }
}

__device__ void phase_norm(const Params& p, int l) {
  const int wave = tidx() >> 6, lane = tidx() & 63;
  const int gw = blockIdx.x * 4 + wave, nw = gridDim.x * 4;
  const float* gn = p.g_norm + l * 1024;
  for (int R = gw; R < NTOK; R += nw) {
    const float* x = xin_row(p, l, R);
    float4 v[4];
    float ss = 0.f;
#pragma unroll
    for (int i = 0; i < 4; ++i) {
      v[i] = *reinterpret_cast<const float4*>(x + i * 256 + lane * 4);
      ss += v[i].x * v[i].x + v[i].y * v[i].y + v[i].z * v[i].z + v[i].w * v[i].w;
    }
    ss = wave_sum(ss);
    const float rstd = rsqrtf(ss * (1.f / 1024.f) + 1e-6f);
    const float* md = ((float*)(p.ws + WS_mod)) + ((size_t)l * 24 + batch_of(R)) * 3072;
#pragma unroll
    for (int i = 0; i < 4; ++i) {
      const int c = i * 256 + lane * 4;
      const float4 g4 = *reinterpret_cast<const float4*>(gn + c);
      const float4 sh = *reinterpret_cast<const float4*>(md + c);
      const float4 sc = *reinterpret_cast<const float4*>(md + 1024 + c);
      uint2 o;
      o.x = pack2h(v[i].x * rstd * g4.x * (1.f + sc.x) + sh.x, v[i].y * rstd * g4.y * (1.f + sc.y) + sh.y);
      o.y = pack2h(v[i].z * rstd * g4.z * (1.f + sc.z) + sh.z, v[i].w * rstd * g4.w * (1.f + sc.w) + sh.w);
      *reinterpret_cast<uint2*>(((u16*)(p.ws + WS_H)) + (size_t)R * 1024 + c) = o;
    }
  }
  const int gtid = blockIdx.x * 256 + tidx(), gstride = gridDim.x * 256;
  {
    const float* ck = p.cache_k + (size_t)l * 16 * 4096 * 512;
    for (int idx = gtid; idx < 16 * 4096 * 512 / 8; idx += gstride) {
      const size_t e = (size_t)idx * 8;
      const int b = (int)(e / (4096 * 512)), rem = (int)(e % (4096 * 512));
      const float4 a = *reinterpret_cast<const float4*>(ck + e), c = *reinterpret_cast<const float4*>(ck + e + 4);
      uint4 o; o.x = pack2(a.x, a.y); o.y = pack2(a.z, a.w); o.z = pack2(c.x, c.y); o.w = pack2(c.z, c.w);
      *reinterpret_cast<uint4*>(((u16*)(p.ws + WS_Ks)) + (size_t)b * KS_ROWS * 512 + rem) = o;
    }
    const float* cki = p.cache_kidx + (size_t)l * 16 * 4096 * 64;
    for (int idx = gtid; idx < 16 * 4096 * 64 / 8; idx += gstride) {
      const size_t e = (size_t)idx * 8;
      const int b = (int)(e / (4096 * 64)), rem = (int)(e % (4096 * 64));
      const float4 a = *reinterpret_cast<const float4*>(cki + e), c = *reinterpret_cast<const float4*>(cki + e + 4);
      uint4 o; o.x = pack2h(a.x, a.y); o.y = pack2h(a.z, a.w); o.z = pack2h(c.x, c.y); o.w = pack2h(c.z, c.w);
      *reinterpret_cast<uint4*>(((u16*)(p.ws + WS_KIs)) + (size_t)b * KIS_ROWS * 64 + rem) = o;
    }
    const float* cv = p.cache_v + (size_t)l * 16 * 4096 * 512;
    for (int idx = gtid; idx < 16 * 512 * 512; idx += gstride) {
      const int c = idx & 511, sb = (idx >> 9) & 511, b = idx >> 18;
      const float* src = cv + ((size_t)b * 4096 + sb * 8) * 512 + c;
      float f[8];
#pragma unroll
      for (int j = 0; j < 8; ++j) f[j] = src[(size_t)j * 512];
      uint4 o; o.x = pack2(f[0], f[1]); o.y = pack2(f[2], f[3]); o.z = pack2(f[4], f[5]); o.w = pack2(f[6], f[7]);
      *reinterpret_cast<uint4*>(((u16*)(p.ws + WS_VTs)) + ((size_t)b * 512 + c) * KS_ROWS + sb * 8) = o;
    }
  }
}

__device__ void phase_inproj(const Params& p, int l, char* lds) {
  const int lane = tidx() & 63, wave = tidx() >> 6, wr = wave >> 1, wc = wave & 1, fr = lane & 15, fq = lane >> 4;
  GemmOrder ord; ord.init(NTOK / 128, 29);
  int mt, nt;
  while (ord.next(mt, nt)) {
    f32x4 acc[4][4];
    zero_acc<4>(acc);
    gemm_accum<4, true>(acc, ((u16*)(p.ws + WS_H)) + (size_t)mt * 128 * 1024, 1024, ((u16*)(p.ws + WS_WinT)) + ((size_t)l * N_IN1P + nt * 128) * 1024, 1024, 1024, reinterpret_cast<u16*>(lds));
    const int region = nt >> 2;
#pragma unroll
    for (int m = 0; m < 4; ++m) {
      const int R0 = mt * 128 + wr * 64 + m * 16 + fq * 4;
      const bool smp = R0 >= NP;
      const int rs = R0 - NP;
      const int b = smp ? (rs >> 5) : (R0 >> 13);
      const int s0 = smp ? (rs & 31) : (R0 & 8191);
#pragma unroll
      for (int n = 0; n < 4; ++n) {
        const int C = nt * 128 + wc * 64 + n * 16 + fr;
        const f32x4 v = acc[m][n];
        if (region == 0) {
#pragma unroll
          for (int j = 0; j < 4; ++j) ((u16*)(p.ws + WS_U))[(size_t)(R0 + j) * 512 + C] = f2bf(v[j]);
        } else if (region == 1) {
#pragma unroll
          for (int j = 0; j < 4; ++j) ((u16*)(p.ws + WS_ZS))[(size_t)(R0 + j) * 512 + (C - 512)] = f2bf(siluf_(v[j]));
        } else if (region == 2) {
#pragma unroll
          for (int j = 0; j < 4; ++j) ((u16*)(p.ws + WS_Q))[(size_t)(R0 + j) * 512 + (C - 1024)] = f2bf(v[j] * 0.18033688011112042f);
        } else if (region == 3) {
          const int cc = C - 1536;
          float* of = smp ? p.out + O_KS + (size_t)l * 262144 + (size_t)rs * 512 + cc : p.out + O_KP + (size_t)l * 33554432 + (size_t)R0 * 512 + cc;
          u16* ob = smp ? ((u16*)(p.ws + WS_Ks)) + ((size_t)b * KS_ROWS + 4096 + s0) * 512 + cc : ((u16*)(p.ws + WS_Kp)) + (size_t)R0 * 512 + cc;
#pragma unroll
          for (int j = 0; j < 4; ++j) { of[(size_t)j * 512] = v[j]; ob[(size_t)j * 512] = f2bf(v[j]); }
        } else if (region == 4) {
          const int cc = C - 2048;
          float* of = smp ? p.out + O_VS + (size_t)l * 262144 + (size_t)rs * 512 + cc : p.out + O_VP + (size_t)l * 33554432 + (size_t)R0 * 512 + cc;
#pragma unroll
          for (int j = 0; j < 4; ++j) of[(size_t)j * 512] = v[j];
          uint2 o; o.x = pack2(v[0], v[1]); o.y = pack2(v[2], v[3]);
          u16* ob = smp ? ((u16*)(p.ws + WS_VTs)) + ((size_t)b * 512 + cc) * KS_ROWS + 4096 + s0 : ((u16*)(p.ws + WS_VTp)) + ((size_t)b * 512 + cc) * 8192 + s0;
          *reinterpret_cast<uint2*>(ob) = o;
        } else if (region == 5) {
#pragma unroll
          for (int j = 0; j < 4; ++j) ((u16*)(p.ws + WS_ZA))[(size_t)(R0 + j) * 512 + (C - 2560)] = f2bf(siluf_(v[j]));
        } else if (region == 6) {
#pragma unroll
          for (int j = 0; j < 4; ++j) ((u16*)(p.ws + WS_QI))[(size_t)(R0 + j) * 512 + (C - 3072)] = f2h(v[j] * 0.125f);
        } else {
          if (C < 3648) {
            const int cc = C - 3584;
            float* of = smp ? p.out + O_KIS + (size_t)l * 32768 + (size_t)rs * 64 + cc : p.out + O_KIP + (size_t)l * 4194304 + (size_t)R0 * 64 + cc;
            u16* ob = smp ? ((u16*)(p.ws + WS_KIs)) + ((size_t)b * KIS_ROWS + 4096 + s0) * 64 + cc : ((u16*)(p.ws + WS_KIp)) + (size_t)R0 * 64 + cc;
#pragma unroll
            for (int j = 0; j < 4; ++j) { of[(size_t)j * 64] = v[j]; ob[(size_t)j * 64] = f2h(v[j]); }
          } else if (C < 3656) {
#pragma unroll
            for (int j = 0; j < 4; ++j) ((float*)(p.ws + WS_WI))[(size_t)(R0 + j) * 8 + (C - 3648)] = v[j] * 0.35355339059327373f;
          }
        }
      }
    }
  }
}

DI void ssm_unit(const Params& p, int l, int g, int row0, int T, float& hr, float& hi, bool write_y, u16* tile) {
  const int lane = tidx() & 63, fr = lane & 15, fq = lane >> 4;
  const int lg = l * 32 + g;
  const float abr = ((float*)(p.ws + WS_ab))[((size_t)lg * 64 + lane) * 2], abi = ((float*)(p.ws + WS_ab))[((size_t)lg * 64 + lane) * 2 + 1];
  const int ntile = T >> 4;
  bf16x8 am[8];
#pragma unroll
  for (int mt = 0; mt < 8; ++mt) am[mt] = fq < 2 ? ldg8(((u16*)(p.ws + WS_Bmat)) + ((size_t)lg * 128 + mt * 16 + fr) * 16 + fq * 8) : zero8();
  bf16x8 bu4[4];
#pragma unroll
  for (int nt = 0; nt < 4; ++nt) bu4[nt] = (fq < 2 && nt < ntile) ? ldg8(((u16*)(p.ws + WS_U)) + (size_t)(row0 + nt * 16 + fr) * 512 + g * 16 + fq * 8) : zero8();
#pragma unroll
  for (int nt = 0; nt < 4; ++nt) {
    if (nt >= ntile) break;
    const bf16x8 bu = bu4[nt];
#pragma unroll
    for (int mt = 0; mt < 8; ++mt) {
      const f32x4 a = mfma16(am[mt], bu, f32x4{0.f, 0.f, 0.f, 0.f});
      uint2 o; o.x = pack2(a[0], a[1]); o.y = pack2(a[2], a[3]);
      *reinterpret_cast<uint2*>(tile + (nt * 16 + fr) * 136 + mt * 16 + fq * 4) = o;
    }
  }
  wave_lds_sync();
  for (int t = 0; t < T; ++t) {
    const float br = bf2f(tile[t * 136 + lane]), bi = bf2f(tile[t * 136 + 64 + lane]);
    const float nhr = fmaf(abr, hr, fmaf(-abi, hi, br));
    const float nhi = fmaf(abr, hi, fmaf(abi, hr, bi));
    hr = nhr; hi = nhi;
    if (write_y) { tile[t * 136 + lane] = f2bf(hr); tile[t * 136 + 64 + lane] = f2bf(hi); }
  }
  if (!write_y) return;
  wave_lds_sync();
  bf16x8 cm[4];
#pragma unroll
  for (int ks = 0; ks < 4; ++ks) cm[ks] = ldg8(((u16*)(p.ws + WS_Cmat)) + ((size_t)lg * 16 + fr) * 128 + ks * 32 + fq * 8);
  const float dsk = p.d_skip[(size_t)lg * 16 + fr];
  u16 uv[4][4];
#pragma unroll
  for (int mt = 0; mt < 4; ++mt)
#pragma unroll
    for (int j = 0; j < 4; ++j) uv[mt][j] = mt < ntile ? ((u16*)(p.ws + WS_U))[(size_t)(row0 + mt * 16 + fq * 4 + j) * 512 + g * 16 + fr] : (u16)0;
  f32x4 ya[4];
#pragma unroll
  for (int mt = 0; mt < 4; ++mt) {
    f32x4 a = {0.f, 0.f, 0.f, 0.f};
    if (mt < ntile) {
#pragma unroll
      for (int ks = 0; ks < 4; ++ks) a = mfma16(*reinterpret_cast<const bf16x8*>(tile + (mt * 16 + fr) * 136 + ks * 32 + fq * 8), cm[ks], a);
    }
    ya[mt] = a;
  }
#pragma unroll
  for (int mt = 0; mt < 4; ++mt) {
    if (mt < ntile) {
#pragma unroll
      for (int j = 0; j < 4; ++j) {
        u16* up = ((u16*)(p.ws + WS_U)) + (size_t)(row0 + mt * 16 + fq * 4 + j) * 512 + g * 16 + fr;
        const float y = ya[mt][j] + dsk * bf2f(uv[mt][j]);
        *up = f2bf(geluf_(y));
      }
    }
  }
  wave_lds_sync();
}

__device__ void indexer_unit(const Params& p, bool smp, int b, int q0, int nkeys, char* lds) {
  const int tid = tidx(), lane = tid & 63, wave = tid >> 6, fr = lane & 15, fq = lane >> 4;
  constexpr int HROW = 1025;
  uint32_t* hist = reinterpret_cast<uint32_t*>(lds);
  u16* maskbuf = reinterpret_cast<u16*>(lds);
  uint32_t* s_pref = reinterpret_cast<uint32_t*>(lds + 16 * HROW * 4);
  uint32_t* s_need = s_pref + 16;
  uint32_t* s_cnt = s_need + 16;
  uint32_t* s_cn = s_cnt + 16;
  uint32_t* s_flag = s_cn + 16;
  uint32_t* s_cand = s_flag + 16;
  constexpr int CAP = 16;
  constexpr int MB = 520;
  const int Rq0 = smp ? NP + b * 32 + q0 : b * 8192 + q0;
  const u16* KI = smp ? ((u16*)(p.ws + WS_KIs)) + (size_t)b * KIS_ROWS * 64 : ((u16*)(p.ws + WS_KIp)) + (size_t)b * 8192 * 64;
  const int ntiles = nkeys >> 4;

  bf16x8 aq[8][2];
#pragma unroll
  for (int h = 0; h < 8; ++h)
#pragma unroll
    for (int ks = 0; ks < 2; ++ks) aq[h][ks] = ldg8(((u16*)(p.ws + WS_QI)) + (size_t)(Rq0 + fr) * 512 + h * 64 + ks * 32 + fq * 8);
  float w[8];
#pragma unroll
  for (int h = 0; h < 8; ++h) w[h] = ((float*)(p.ws + WS_WI))[(size_t)(Rq0 + fr) * 8 + h];

  bf16x8 nb0 = zero8(), nb1 = zero8();
  auto load_keys = [&](int kt) {
    const u16* kp = KI + (size_t)(kt * 16 + fr) * 64 + fq * 8;
    nb0 = ldg8(kp); nb1 = ldg8(kp + 32);
  };
  auto score_keys = [&](int kt, uint32_t (&key)[4]) {
    const bf16x8 b0 = nb0, b1 = nb1;
    if (kt + 4 < ntiles) load_keys(kt + 4);
    float sc[4] = {0.f, 0.f, 0.f, 0.f};
#pragma unroll
    for (int h = 0; h < 8; ++h) {
      f32x4 a = mfma16h(b0, aq[h][0], f32x4{0.f, 0.f, 0.f, 0.f});
      a = mfma16h(b1, aq[h][1], a);
#pragma unroll
      for (int j = 0; j < 4; ++j) sc[j] = fmaf(w[h], __builtin_amdgcn_fmed3f(a[j], 0.f, 3.0e38f), sc[j]);
    }
#pragma unroll
    for (int j = 0; j < 4; ++j) {
      const uint32_t uu = __float_as_uint(sc[j]);
      key[j] = (uu & 0x80000000u) ? ~uu : (uu | 0x80000000u);
    }
  };

  __syncthreads();
  if (tid < 16) { s_pref[tid] = 0u; s_need[tid] = 256u; s_cn[tid] = 0u; if (tid == 0) s_flag[0] = 0u; }
  if (nkeys > 256) {
#pragma unroll 1
    for (int pass = 0; pass < 3; ++pass) {
      if (pass == 2 && s_flag[0] == 0u) break;
      for (int i = tid; i < 16 * HROW / 4; i += 256) reinterpret_cast<uint4*>(hist)[i] = uint4{0u, 0u, 0u, 0u};
      __syncthreads();
      const uint32_t pref = s_pref[fr];
      const int mshift = pass == 0 ? 32 : (pass == 1 ? 21 : 10);
      const int bshift = pass == 0 ? 21 : (pass == 1 ? 10 : 0);
      const uint32_t bmask = pass == 2 ? 1023u : 2047u;
      if (wave < ntiles) load_keys(wave);
      for (int kt = wave; kt < ntiles; kt += 4) {
        uint32_t key[4];
        score_keys(kt, key);
#pragma unroll
        for (int j = 0; j < 4; ++j) {
          const bool match = pass == 0 ? true : ((key[j] >> mshift) == pref);
          if (match) {
            const uint32_t bin = (key[j] >> bshift) & bmask;
            atomicAdd(&hist[fr * HROW + (bin >> 1)], (bin & 1u) ? 0x10000u : 1u);
          }
        }
      }
      __syncthreads();
      {
        const int q = tid >> 4, part = tid & 15;
        const int nb = pass == 2 ? 1024 : 2048;
        const int per = nb >> 4;
        const uint32_t* hq = hist + q * HROW;
        uint32_t mysum = 0;
        for (int wd = (part * per) >> 1; wd < ((part + 1) * per) >> 1; ++wd) { const uint32_t x = hq[wd]; mysum += (x & 0xffffu) + (x >> 16); }
        uint32_t v = mysum;
#pragma unroll
        for (int d = 1; d < 16; d <<= 1) { const uint32_t t2 = __shfl_down(v, d, 16); if (part + d < 16) v += t2; }
        const uint32_t above = v - mysum;
        const uint32_t need = s_need[q];
        const uint32_t prefq = s_pref[q];
        __syncthreads();
        if (above < need && need <= above + mysum) {
          uint32_t c = above;
          for (int bin = (part + 1) * per - 1; bin >= part * per; --bin) {
            const uint32_t cnt = (hq[bin >> 1] >> ((bin & 1) * 16)) & 0xffffu;
            if (c + cnt >= need) {
              s_pref[q] = (prefq << (pass == 2 ? 10 : 11)) | (uint32_t)bin;
              s_need[q] = need - c;
              if (pass == 1) { s_cnt[q] = cnt; if (cnt > (uint32_t)CAP) s_flag[0] = 1u; }
              break;
            }
            c += cnt;
          }
        }
        __syncthreads();
      }
    }
  } else {
    __syncthreads();
  }
  const bool fast = (nkeys > 256) && (s_flag[0] == 0u);
  const uint32_t thr = s_pref[fr];
  __syncthreads();
  const int nw16 = smp ? 260 : ntiles;
  if (wave < ntiles) load_keys(wave);
  for (int kt = wave; kt < nw16; kt += 4) {
    uint32_t word = 0;
    if (kt < ntiles) {
      uint32_t key[4];
      score_keys(kt, key);
      if (fast) {
#pragma unroll
        for (int j = 0; j < 4; ++j) {
          const uint32_t k22 = key[j] >> 10;
          word |= (k22 > thr ? 1u : 0u) << (fq * 4 + j);
          if (k22 == thr) {
            const uint32_t ci = atomicAdd(&s_cn[fr], 1u);
            if (ci < (uint32_t)CAP) s_cand[fr * CAP + ci] = (key[j] & 1023u) | ((uint32_t)(kt * 16 + fq * 4 + j) << 10);
          }
        }
      } else {
#pragma unroll
        for (int j = 0; j < 4; ++j) word |= (key[j] >= thr ? 1u : 0u) << (fq * 4 + j);
      }
      word |= __shfl_xor(word, 16);
      word |= __shfl_xor(word, 32);
    }
    if (fq == 0) maskbuf[fr * MB + kt] = (u16)word;
  }
  __syncthreads();
  if (fast) {
    if (tid < 16) {
      const uint32_t n = s_cn[tid] < (uint32_t)CAP ? s_cn[tid] : (uint32_t)CAP, need = s_need[tid];
      for (uint32_t i = 0; i < n; ++i) {
        const uint32_t ci = s_cand[tid * CAP + i], vi = ci & 1023u;
        uint32_t greater = 0;
        for (uint32_t k = 0; k < n; ++k) greater += ((s_cand[tid * CAP + k] & 1023u) > vi) ? 1u : 0u;
        if (greater < need) {
          const uint32_t pos = ci >> 10;
          maskbuf[tid * MB + (pos >> 4)] |= (u16)(1u << (pos & 15u));
        }
      }
    }
    __syncthreads();
  }
  {
    const int n8 = nw16 >> 2;
    for (int i = tid; i < 16 * n8; i += 256) {
      const int q = i / n8, c = i % n8;
      const uint2 vv = *reinterpret_cast<const uint2*>(maskbuf + q * MB + c * 4);
      u16* dst = smp ? ((u16*)(p.ws + WS_masks)) + (size_t)(b * 32 + q0 + q) * MS_ROW : ((u16*)(p.ws + WS_maskp)) + (size_t)(b * 8192 + q0 + q) * 512;
      *reinterpret_cast<uint2*>(dst + c * 4) = vv;
    }
  }
}

__device__ void ssm_local_scan(const Params& p, int l, int b, int c, int g) {
  const int lane = tidx() & 63;
  const int lg = l * 32 + g;
  const float abr = ((float*)(p.ws + WS_ab))[((size_t)lg * 64 + lane) * 2], abi = ((float*)(p.ws + WS_ab))[((size_t)lg * 64 + lane) * 2 + 1];
  float bbr[16], bbi[16];
#pragma unroll
  for (int n = 0; n < 16; ++n) {
    bbr[n] = ((float*)(p.ws + WS_BbF))[(((size_t)lg * 2 + 0) * 16 + n) * 64 + lane];
    bbi[n] = ((float*)(p.ws + WS_BbF))[(((size_t)lg * 2 + 1) * 16 + n) * 64 + lane];
  }
  float hr = 0.f, hi = 0.f;
  const u16* up = ((u16*)(p.ws + WS_U)) + ((size_t)b * 8192 + (size_t)c * 64) * 512 + g * 16;
  u32x4 cur[8], nxt[8];
#pragma unroll
  for (int k = 0; k < 4; ++k) {
    cur[2 * k] = *reinterpret_cast<const u32x4*>(up + (size_t)k * 512);
    cur[2 * k + 1] = *reinterpret_cast<const u32x4*>(up + (size_t)k * 512 + 8);
  }
  for (int t4 = 0; t4 < 16; ++t4) {
    if (t4 + 1 < 16) {
#pragma unroll
      for (int k = 0; k < 4; ++k) {
        nxt[2 * k] = *reinterpret_cast<const u32x4*>(up + (size_t)((t4 + 1) * 4 + k) * 512);
        nxt[2 * k + 1] = *reinterpret_cast<const u32x4*>(up + (size_t)((t4 + 1) * 4 + k) * 512 + 8);
      }
    }
#pragma unroll
    for (int k = 0; k < 4; ++k) {
      float br = 0.f, bi = 0.f;
#pragma unroll
      for (int h2 = 0; h2 < 2; ++h2) {
        const u32x4 w = cur[2 * k + h2];
#pragma unroll
        for (int d = 0; d < 4; ++d) {
          const float x0 = __uint_as_float(w[d] << 16), x1 = __uint_as_float(w[d] & 0xffff0000u);
          const int n = h2 * 8 + d * 2;
          br = fmaf(bbr[n], x0, br); bi = fmaf(bbi[n], x0, bi);
          br = fmaf(bbr[n + 1], x1, br); bi = fmaf(bbi[n + 1], x1, bi);
        }
      }
      const float nhr = fmaf(abr, hr, fmaf(-abi, hi, br));
      const float nhi = fmaf(abr, hi, fmaf(abi, hr, bi));
      hr = nhr; hi = nhi;
    }
#pragma unroll
    for (int k = 0; k < 8; ++k) cur[k] = nxt[k];
  }
  const size_t o = ((size_t)(b * 128 + c) * 32 + g) * 64 + lane;
  ((float*)(p.ws + WS_SlocR))[o] = hr; ((float*)(p.ws + WS_SlocI))[o] = hi;
}

__device__ void phase_ssmA_indexer(const Params& p, int l, char* lds) {
  const int wave = tidx() >> 6;
  const int x = blockIdx.x & 7, j = blockIdx.x >> 3, nb = gridDim.x >> 3;
  if (blockIdx.x < 32) indexer_unit(p, true, blockIdx.x >> 1, (blockIdx.x & 1) * 16, 4128, lds);
  for (int tlo = j; tlo < 256; tlo += nb) {
    const int th = 511 - tlo;
    indexer_unit(p, false, x, th * 16, ((th >> 2) + 1) * 64, lds);
    indexer_unit(p, false, x, tlo * 16, ((tlo >> 2) + 1) * 64, lds);
  }
  for (int u = blockIdx.x; u < 8192; u += gridDim.x) {
    const int wu = u * 4 + wave;
    ssm_local_scan(p, l, wu >> 12, (wu >> 5) & 127, wu & 31);
  }
}

DI bf16x8 pack8_bf16(float a0, float a1, float a2, float a3, float a4, float a5, float a6, float a7) {
  u32x4 r;
  asm("v_cvt_pk_bf16_f32 %0, %4, %5\n\tv_cvt_pk_bf16_f32 %1, %6, %7\n\tv_cvt_pk_bf16_f32 %2, %8, %9\n\tv_cvt_pk_bf16_f32 %3, %10, %11\n\ts_nop 1"
      : "=&v"(r[0]), "=&v"(r[1]), "=&v"(r[2]), "=&v"(r[3])
      : "v"(a0), "v"(a1), "v"(a2), "v"(a3), "v"(a4), "v"(a5), "v"(a6), "v"(a7));
  return __builtin_bit_cast(bf16x8, r);
}

__device__ void attn_unit(const Params& p, bool smp, int b, int chunk, int h, char* lds) {
  constexpr int LR = 72;
  constexpr int STG = 128 * LR;
  const int tid = tidx(), lane = tid & 63, wave = tid >> 6, fr = lane & 15, fq = lane >> 4;
  u16* sbase = reinterpret_cast<u16*>(lds);
  const int nq = smp ? 32 : 64;
  const int nkeys = smp ? 4128 : 64 * (chunk + 1);
  const int ntile = (nkeys + 63) >> 6;
  const int Rq0 = smp ? NP + b * 32 : b * 8192 + chunk * 64;
  const u16* Kb = (smp ? ((u16*)(p.ws + WS_Ks)) + (size_t)b * KS_ROWS * 512 : ((u16*)(p.ws + WS_Kp)) + (size_t)b * 8192 * 512) + h * 64;
  const int Sv = smp ? KS_ROWS : 8192;
  const u16* Vb = smp ? ((u16*)(p.ws + WS_VTs)) + ((size_t)b * 512 + h * 64) * KS_ROWS : ((u16*)(p.ws + WS_VTp)) + ((size_t)b * 512 + h * 64) * 8192;
  const bool active = wave * 16 < nq;
  const int qrow = active ? wave * 16 : 0;
  bf16x8 aq[2];
#pragma unroll
  for (int ks = 0; ks < 2; ++ks) aq[ks] = ldg8(((u16*)(p.ws + WS_Q)) + (size_t)(Rq0 + qrow + fr) * 512 + h * 64 + ks * 32 + fq * 8);
  const u16* mrow = smp ? ((u16*)(p.ws + WS_masks)) + (size_t)(b * 32 + qrow + fr) * MS_ROW
                        : ((u16*)(p.ws + WS_maskp)) + (size_t)(b * 8192 + chunk * 64 + qrow + fr) * 512;
  const int srow = tid >> 3, sch = tid & 7;
  u32x4 rk[2], rv[2];
  u32x2 mk;
  auto gload = [&](int kt) {
#pragma unroll
    for (int i = 0; i < 2; ++i) {
      rk[i] = *reinterpret_cast<const u32x4*>(Kb + (size_t)(kt * 64 + srow + i * 32) * 512 + sch * 8);
      rv[i] = *reinterpret_cast<const u32x4*>(Vb + (size_t)(srow + i * 32) * Sv + kt * 64 + sch * 8);
    }
    mk = *reinterpret_cast<const u32x2*>(mrow + kt * 4);
  };
  auto lstore = [&](int buf) {
    u16* sK = sbase + buf * STG;
    u16* sV = sK + 64 * LR;
#pragma unroll
    for (int i = 0; i < 2; ++i) {
      *reinterpret_cast<u32x4*>(sK + (srow + i * 32) * LR + sch * 8) = rk[i];
      *reinterpret_cast<u32x4*>(sV + (srow + i * 32) * LR + sch * 8) = rv[i];
    }
  };
  f32x4 Ot[4];
#pragma unroll
  for (int n = 0; n < 4; ++n) Ot[n] = f32x4{0.f, 0.f, 0.f, 0.f};
  float mrun = -1e29f, lrun = 0.f;
  gload(0);
  __syncthreads();
  lstore(0);
  u32x2 mcur = mk;
  if (ntile > 1) gload(1);
  __syncthreads();
  for (int kt = 0; kt < ntile; ++kt) {
    const int cur = kt & 1;
    const u32x2 mthis = mcur;
    if (kt + 1 < ntile) { lstore(cur ^ 1); mcur = mk; }
    if (kt + 2 < ntile) gload(kt + 2);
    if (active) {
      const u16* sK = sbase + cur * STG;
      const u16* sV = sK + 64 * LR;
      f32x4 st[4];
#pragma unroll
      for (int n = 0; n < 4; ++n) {
        f32x4 a = {0.f, 0.f, 0.f, 0.f};
#pragma unroll
        for (int ks = 0; ks < 2; ++ks) a = mfma16(*reinterpret_cast<const bf16x8*>(sK + (n * 16 + fr) * LR + ks * 32 + fq * 8), aq[ks], a);
        st[n] = a;
      }
      float mx = -1e30f;
#pragma unroll
      for (int n = 0; n < 4; ++n) {
        const uint32_t nib = ((n < 2 ? mthis[0] : mthis[1]) >> ((n & 1) * 16 + fq * 4)) & 15u;
#pragma unroll
        for (int j = 0; j < 4; ++j) {
          st[n][j] = (nib & (1u << j)) ? st[n][j] : -1e30f;
          mx = fmaxf(mx, st[n][j]);
        }
      }
      mx = fmaxf(mx, __shfl_xor(mx, 16));
      mx = fmaxf(mx, __shfl_xor(mx, 32));
      const float mnew = fmaxf(mrun, mx);
      const float alpha = __builtin_amdgcn_exp2f(mrun - mnew);
      mrun = mnew;
      float ps = 0.f;
#pragma unroll
      for (int n = 0; n < 4; ++n)
#pragma unroll
        for (int j = 0; j < 4; ++j) { st[n][j] = __builtin_amdgcn_exp2f(st[n][j] - mnew); ps += st[n][j]; }
      lrun = lrun * alpha + ps;
#pragma unroll
      for (int n = 0; n < 4; ++n)
#pragma unroll
        for (int j = 0; j < 4; ++j) Ot[n][j] *= alpha;
#pragma unroll
      for (int ks = 0; ks < 2; ++ks) {
        const bf16x8 pb = pack8_bf16(st[2 * ks][0], st[2 * ks][1], st[2 * ks][2], st[2 * ks][3],
                                     st[2 * ks + 1][0], st[2 * ks + 1][1], st[2 * ks + 1][2], st[2 * ks + 1][3]);
#pragma unroll
        for (int dt = 0; dt < 4; ++dt) {
          const u16* vr = sV + (dt * 16 + fr) * LR + ks * 32 + fq * 4;
          const u32x2 v0 = *reinterpret_cast<const u32x2*>(vr), v1 = *reinterpret_cast<const u32x2*>(vr + 16);
          const u32x4 vv = {v0[0], v0[1], v1[0], v1[1]};
          Ot[dt] = mfma16(__builtin_bit_cast(bf16x8, vv), pb, Ot[dt]);
        }
      }
    }
    __syncthreads();
  }
  if (active) {
    float ls = lrun;
    ls += __shfl_xor(ls, 16); ls += __shfl_xor(ls, 32);
    const float inv = 1.f / ls;
    const size_t ro = (size_t)(Rq0 + qrow + fr) * 512 + h * 64;
    u32x2 zz4[4];
#pragma unroll
    for (int dt = 0; dt < 4; ++dt) zz4[dt] = *reinterpret_cast<const u32x2*>(((u16*)(p.ws + WS_ZA)) + ro + dt * 16 + fq * 4);
#pragma unroll
    for (int dt = 0; dt < 4; ++dt) {
      const size_t o = ro + dt * 16 + fq * 4;
      const u32x2 zz = zz4[dt];
      const float z0 = __uint_as_float(zz[0] << 16), z1 = __uint_as_float(zz[0] & 0xffff0000u);
      const float z2 = __uint_as_float(zz[1] << 16), z3 = __uint_as_float(zz[1] & 0xffff0000u);
      u32x2 ov;
      ov[0] = pack2(Ot[dt][0] * inv * z0, Ot[dt][1] * inv * z1);
      ov[1] = pack2(Ot[dt][2] * inv * z2, Ot[dt][3] * inv * z3);
      *reinterpret_cast<u32x2*>(((u16*)(p.ws + WS_Q)) + o) = ov;
    }
  }
}

__device__ void phase_ssmB_attn(const Params& p, int l, char* lds) {
  const int x = blockIdx.x & 7, j = blockIdx.x >> 3, nb = gridDim.x >> 3;
  if (blockIdx.x >= gridDim.x - 64) {
    const int t = (gridDim.x - 1 - blockIdx.x) * 256 + tidx();
    const int pp = t & 63, g = (t >> 6) & 31, b = t >> 11;
    float ar = ((float*)(p.ws + WS_ab))[((size_t)(l * 32 + g) * 64 + pp) * 2], ai = ((float*)(p.ws + WS_ab))[((size_t)(l * 32 + g) * 64 + pp) * 2 + 1];
#pragma unroll
    for (int i = 0; i < 6; ++i) { const float nr = ar * ar - ai * ai, ni = 2.f * ar * ai; ar = nr; ai = ni; }
    float hr = 0.f, hi = 0.f;
    for (int c8 = 0; c8 < 128; c8 += 8) {
      float sr[8], si[8];
#pragma unroll
      for (int k = 0; k < 8; ++k) {
        const size_t o = ((size_t)(b * 128 + c8 + k) * 32 + g) * 64 + pp;
        sr[k] = ((float*)(p.ws + WS_SlocR))[o]; si[k] = ((float*)(p.ws + WS_SlocI))[o];
      }
#pragma unroll
      for (int k = 0; k < 8; ++k) {
        const size_t o = ((size_t)(b * 128 + c8 + k) * 32 + g) * 64 + pp;
        ((float*)(p.ws + WS_HstR))[o] = hr; ((float*)(p.ws + WS_HstI))[o] = hi;
        const float nhr = ar * hr - ai * hi + sr[k], nhi = ar * hi + ai * hr + si[k];
        hr = nhr; hi = nhi;
      }
    }
    p.out[O_SRP + (size_t)l * 16384 + (size_t)(b * 32 + g) * 64 + pp] = hr;
    p.out[O_SIP + (size_t)l * 16384 + (size_t)(b * 32 + g) * 64 + pp] = hi;
  }
  if (blockIdx.x < 128) attn_unit(p, true, blockIdx.x >> 3, 0, blockIdx.x & 7, lds);
  for (int pi = 0; pi < 8; ++pi) {
    const int pair = x + 8 * pi, b = pair >> 3, h = pair & 7;
    for (int c = j; c < 64; c += nb) {
      attn_unit(p, false, b, 127 - c, h, lds);
      attn_unit(p, false, b, c, h, lds);
    }
  }
}

__device__ void phase_ssmC(const Params& p, int l, char* lds) {
  const int wave = tidx() >> 6, lane = tidx() & 63;
  const int NU = (32768 + 512) / 4;
  for (int u = blockIdx.x; u < NU; u += gridDim.x) {
    const int wu = u * 4 + wave;
    u16* tile = reinterpret_cast<u16*>(lds) + wave * (64 * 136);
    if (wu < 32768) {
      const int g = wu & 31, c = (wu >> 5) & 127, b = wu >> 12;
      const size_t o = ((size_t)(b * 128 + c) * 32 + g) * 64 + lane;
      float hr = ((float*)(p.ws + WS_HstR))[o], hi = ((float*)(p.ws + WS_HstI))[o];
      ssm_unit(p, l, g, b * 8192 + c * 64, 64, hr, hi, true, tile);
    } else {
      const int i = wu - 32768;
      const int g = i & 31, b = i >> 5;
      const size_t si = ((size_t)(l * 16 + b) * 32 + g) * 64 + lane;
      float hr = p.st_re[si], hi = p.st_im[si];
      ssm_unit(p, l, g, NP + b * 32, 32, hr, hi, true, tile);
      p.out[O_SRS + si] = hr;
      p.out[O_SIS + si] = hi;
    }
  }
}

__device__ void phase_glu(const Params& p, int l, char* lds) {
  const int lane = tidx() & 63, wave = tidx() >> 6, wr = wave >> 1, wc = wave & 1, fr = lane & 15, fq = lane >> 4;
  GemmOrder ord; ord.init(NTOK / 128, 4);
  int mt, nt;
  while (ord.next(mt, nt)) {
    f32x4 acc[4][4];
    zero_acc<4>(acc);
    gemm_accum<4>(acc, ((u16*)(p.ws + WS_U)) + (size_t)mt * 128 * 512, 512, ((u16*)(p.ws + WS_WgluT)) + ((size_t)l * 512 + nt * 128) * 512, 512, 512, reinterpret_cast<u16*>(lds));
    float bg[4];
#pragma unroll
    for (int n = 0; n < 4; ++n) bg[n] = p.b_glu[l * 512 + nt * 128 + wc * 64 + n * 16 + fr];
#pragma unroll
    for (int m = 0; m < 4; ++m) {
      u16 yv[4][4], zv[4][4];
#pragma unroll
      for (int n = 0; n < 4; ++n)
#pragma unroll
        for (int j = 0; j < 4; ++j) {
          const size_t o = (size_t)(mt * 128 + wr * 64 + m * 16 + fq * 4 + j) * 512 + nt * 128 + wc * 64 + n * 16 + fr;
          yv[n][j] = ((u16*)(p.ws + WS_U))[o];
          zv[n][j] = ((u16*)(p.ws + WS_ZS))[o];
        }
#pragma unroll
      for (int n = 0; n < 4; ++n)
#pragma unroll
        for (int j = 0; j < 4; ++j) {
          const size_t o = (size_t)(mt * 128 + wr * 64 + m * 16 + fq * 4 + j) * 512 + nt * 128 + wc * 64 + n * 16 + fr;
          ((u16*)(p.ws + WS_ZS))[o] = f2bf(bf2f(yv[n][j]) * sigmoidf_(acc[m][n][j] + bg[n]) * bf2f(zv[n][j]));
        }
    }
  }
}
__device__ void phase_merge(const Params& p, int l, char* lds) {
  const int lane = tidx() & 63, wave = tidx() >> 6, wr = wave >> 1, wc = wave & 1, fr = lane & 15, fq = lane >> 4;
  u16* L = reinterpret_cast<u16*>(lds);
  GemmOrder ord; ord.init(NTOK / 128, 16);
  int mt, nt;
  while (ord.next(mt, nt)) {
    f32x4 acc[4][2], res[4][2];
    zero_acc<2>(acc);
    gemm_accum<2, true>(acc, ((u16*)(p.ws + WS_H)) + (size_t)mt * 128 * 1024, 1024, ((u16*)(p.ws + WS_WgT)) + ((size_t)l * 2048 + nt * 64) * 1024, 1024, 1024, L);
#pragma unroll
    for (int m = 0; m < 4; ++m)
#pragma unroll
      for (int n = 0; n < 2; ++n)
#pragma unroll
        for (int j = 0; j < 4; ++j) res[m][n][j] = sigmoidf_(acc[m][n][j]);
    zero_acc<2>(acc);
    gemm_accum<2>(acc, ((u16*)(p.ws + WS_ZS)) + (size_t)mt * 128 * 512, 512, ((u16*)(p.ws + WS_WpsT)) + ((size_t)l * 1024 + nt * 64) * 512, 512, 512, L);
#pragma unroll
    for (int m = 0; m < 4; ++m)
#pragma unroll
      for (int n = 0; n < 2; ++n)
#pragma unroll
        for (int j = 0; j < 4; ++j) res[m][n][j] *= acc[m][n][j];
    f32x4 gt[4][2];
    zero_acc<2>(gt);
    gemm_accum<2, true>(gt, ((u16*)(p.ws + WS_H)) + (size_t)mt * 128 * 1024, 1024, ((u16*)(p.ws + WS_WgT)) + ((size_t)l * 2048 + 1024 + nt * 64) * 1024, 1024, 1024, L);
    zero_acc<2>(acc);
    gemm_accum<2>(acc, ((u16*)(p.ws + WS_Q)) + (size_t)mt * 128 * 512, 512, ((u16*)(p.ws + WS_WpaT)) + ((size_t)l * 1024 + nt * 64) * 512, 512, 512, L);
#pragma unroll
    for (int m = 0; m < 4; ++m)
#pragma unroll
      for (int n = 0; n < 2; ++n) {
        const int C = nt * 64 + wc * 32 + n * 16 + fr;
#pragma unroll
        for (int j = 0; j < 4; ++j) {
          const float v = res[m][n][j] + sigmoidf_(gt[m][n][j]) * acc[m][n][j];
          ((u16*)(p.ws + WS_U))[(size_t)(mt * 128 + wr * 64 + m * 16 + fq * 4 + j) * 1024 + C] = f2bf(v);
        }
      }
  }
}

__device__ void phase_out(const Params& p, int l, char* lds) {
  const int lane = tidx() & 63, wave = tidx() >> 6, wr = wave >> 1, wc = wave & 1, fr = lane & 15, fq = lane >> 4;
  GemmOrder ord; ord.init(NTOK / 128, 8);
  int mt, nt;
  while (ord.next(mt, nt)) {
    f32x4 acc[4][4];
    zero_acc<4>(acc);
    gemm_accum<4>(acc, ((u16*)(p.ws + WS_U)) + (size_t)mt * 128 * 1024, 1024, ((u16*)(p.ws + WS_WoT)) + ((size_t)l * 1024 + nt * 128) * 1024, 1024, 1024, reinterpret_cast<u16*>(lds));
    float xo[4][4][4];
#pragma unroll
    for (int m = 0; m < 4; ++m) {
      const int R0 = mt * 128 + wr * 64 + m * 16 + fq * 4;
#pragma unroll
      for (int j = 0; j < 4; ++j) {
        const float* xr = xin_row(p, l, R0 + j) + nt * 128 + wc * 64 + fr;
#pragma unroll
        for (int n = 0; n < 4; ++n) xo[m][n][j] = xr[n * 16];
      }
    }
#pragma unroll
    for (int m = 0; m < 4; ++m) {
      const int R0 = mt * 128 + wr * 64 + m * 16 + fq * 4;
      const float* gate = ((float*)(p.ws + WS_mod)) + ((size_t)l * 24 + batch_of(R0)) * 3072 + 2048;
#pragma unroll
      for (int n = 0; n < 4; ++n) {
        const int C = nt * 128 + wc * 64 + n * 16 + fr;
        const float gv = gate[C];
#pragma unroll
        for (int j = 0; j < 4; ++j) p.out[(size_t)(R0 + j) * 1024 + C] = xo[m][n][j] + gv * acc[m][n][j];
      }
    }
  }
}

__device__ void phase_final(const Params& p) {
  const int wave = tidx() >> 6, lane = tidx() & 63;
  const int gw = blockIdx.x * 4 + wave, nw = gridDim.x * 4;
  for (int R = gw; R < NTOK; R += nw) {
    float* x = p.out + (size_t)R * 1024;
    float4 v[4];
    float ss = 0.f;
#pragma unroll
    for (int i = 0; i < 4; ++i) {
      v[i] = *reinterpret_cast<const float4*>(x + i * 256 + lane * 4);
      ss += v[i].x * v[i].x + v[i].y * v[i].y + v[i].z * v[i].z + v[i].w * v[i].w;
    }
    ss = wave_sum(ss);
    const float rstd = rsqrtf(ss * (1.f / 1024.f) + 1e-6f);
#pragma unroll
    for (int i = 0; i < 4; ++i) {
      const int c = i * 256 + lane * 4;
      const float4 g4 = *reinterpret_cast<const float4*>(p.g_final + c);
      float4 o;
      o.x = v[i].x * rstd * g4.x; o.y = v[i].y * rstd * g4.y; o.z = v[i].z * rstd * g4.z; o.w = v[i].w * rstd * g4.w;
      *reinterpret_cast<float4*>(x + c) = o;
    }
  }
}

__global__ void __launch_bounds__(256, 2) fwd_megakernel(Params p) {
  extern __shared__ __attribute__((aligned(16))) char lds[];
  cg::grid_group grid = cg::this_grid();
  for (int ph = p.phase_lo; ph <= p.phase_hi; ++ph) {
    if (ph > p.phase_lo) grid.sync();
    Params q = p;
#define LAUNDER(f) asm volatile("" : "+s"(q.f))
    LAUNDER(x_prompt); LAUNDER(x_sample); LAUNDER(cache_k); LAUNDER(cache_v); LAUNDER(cache_kidx); LAUNDER(st_re); LAUNDER(st_im);
    LAUNDER(c_prompt); LAUNDER(c_sample); LAUNDER(w_mod); LAUNDER(b_mod); LAUNDER(g_norm); LAUNDER(w_in); LAUNDER(a_re); LAUNDER(a_im);
    LAUNDER(log_dt); LAUNDER(b_re); LAUNDER(b_im); LAUNDER(c_re); LAUNDER(c_im); LAUNDER(d_skip); LAUNDER(w_glu); LAUNDER(b_glu);
    LAUNDER(w_ps); LAUNDER(w_pa); LAUNDER(w_o); LAUNDER(g_final); LAUNDER(out); LAUNDER(ws);
#undef LAUNDER
    if (ph == 0) phase_prep(q, lds);
    else if (ph == NPHASE - 1) phase_final(q);
    else {
      const int l = (ph - 1) >> 3, s = (ph - 1) & 7;
      switch (s) {
        case 0: phase_norm(q, l); break;
        case 1: phase_inproj(q, l, lds); break;
        case 2: phase_ssmA_indexer(q, l, lds); break;
        case 3: phase_ssmB_attn(q, l, lds); break;
        case 4: phase_ssmC(q, l, lds); break;
        case 5: phase_glu(q, l, lds); break;
        case 6: phase_merge(q, l, lds); break;
        default: phase_out(q, l, lds); break;
      }
    }
  }
}

extern "C" void kernel_launch(void* const* d_in, const int* in_sizes, int n_in, void* d_out, int out_size, void* d_ws, size_t ws_size,
                              hipStream_t stream) {
  static int grid_blocks = 0;
  if (!grid_blocks) {
    int dev = 0, cus = 0, per_cu = 0;
    hipGetDevice(&dev);
    hipDeviceGetAttribute(&cus, hipDeviceAttributeMultiprocessorCount, dev);
    hipFuncSetAttribute((const void*)fwd_megakernel, hipFuncAttributeMaxDynamicSharedMemorySize, LDS_BYTES);
    hipOccupancyMaxActiveBlocksPerMultiprocessor(&per_cu, (const void*)fwd_megakernel, 256, LDS_BYTES);
    if (per_cu < 1) per_cu = 1;
    if (per_cu > 2) per_cu = 2;
    grid_blocks = cus * per_cu;
  }
  Params p{};
  const float* const* in = reinterpret_cast<const float* const*>(d_in);
  p.x_prompt = in[0]; p.x_sample = in[1]; p.cache_k = in[2]; p.cache_v = in[3]; p.cache_kidx = in[4];
  p.st_re = in[5]; p.st_im = in[6]; p.c_prompt = in[7]; p.c_sample = in[8];
  p.w_mod = in[9]; p.b_mod = in[10]; p.g_norm = in[11]; p.w_in = in[12]; p.a_re = in[13]; p.a_im = in[14]; p.log_dt = in[15];
  p.b_re = in[16]; p.b_im = in[17]; p.c_re = in[18]; p.c_im = in[19]; p.d_skip = in[20];
  p.w_glu = in[21]; p.b_glu = in[22]; p.w_ps = in[23]; p.w_pa = in[24]; p.w_o = in[25]; p.g_final = in[26];
  p.out = (float*)d_out;
  p.ws = (char*)d_ws;
  if (WS_TOTAL > ws_size) fprintf(stderr, "kernel_launch: workspace too small: need %zu have %zu\n", (size_t)WS_TOTAL, ws_size);
#if MULTI_LAUNCH
  for (int ph = 0; ph < NPHASE; ++ph) {
    p.phase_lo = ph; p.phase_hi = ph;
    hipLaunchKernelGGL(fwd_megakernel, dim3(grid_blocks), dim3(256), LDS_BYTES, stream, p);
  }
#else
  p.phase_lo = 0; p.phase_hi = NPHASE - 1;
  void* args[] = {&p};
  hipError_t e = hipLaunchCooperativeKernel((void*)fwd_megakernel, dim3(grid_blocks), dim3(256), args, LDS_BYTES, stream);
  if (e != hipSuccess) fprintf(stderr, "cooperative launch failed: %s (grid %d)\n", hipGetErrorString(e), grid_blocks);
#endif
}
```

```cpp
#include <hip/hip_runtime.h>
#include <hip/hip_cooperative_groups.h>
#include <stdint.h>
#include <stdio.h>
namespace cg = cooperative_groups;

#ifndef MULTI_LAUNCH
#define MULTI_LAUNCH 0
#endif

#define DI __device__ __forceinline__
typedef __attribute__((ext_vector_type(8))) short bf16x8;
typedef __attribute__((ext_vector_type(4))) float f32x4;
typedef unsigned short u16;
typedef __attribute__((ext_vector_type(4))) unsigned u32x4;
typedef __attribute__((ext_vector_type(2))) unsigned u32x2;

constexpr int NP = 65536, NS = 512, NTOK = NP + NS;
constexpr int D_IN = 5704, N_IN1 = 3656, N_IN1P = 3712;
constexpr int KS_ROWS = 4160, KIS_ROWS = 4128, MS_ROW = 264;
constexpr int LDS_BYTES = 73728;
constexpr int NPHASE = 18;

constexpr size_t O_KP = 67633152, O_VP = 134742016, O_KIP = 201850880, O_SRP = 210239488, O_SIP = 210272256,
                 O_KS = 210305024, O_VS = 210829312, O_KIS = 211353600, O_SRS = 211419136, O_SIS = 211484672;

struct Params {
  const float *x_prompt, *x_sample, *cache_k, *cache_v, *cache_kidx, *st_re, *st_im, *c_prompt, *c_sample;
  const float *w_mod, *b_mod, *g_norm, *w_in, *a_re, *a_im, *log_dt, *b_re, *b_im, *c_re, *c_im, *d_skip;
  const float *w_glu, *b_glu, *w_ps, *w_pa, *w_o, *g_final;
  float* out;
  char* ws;
  int phase_lo, phase_hi;
};
constexpr size_t al256(size_t x) { return (x + 255) & ~(size_t)255; }
constexpr size_t WS_WinT = 0;
constexpr size_t WS_WgT = WS_WinT + al256((size_t)2 * N_IN1P * 1024 * 2);
constexpr size_t WS_WgluT = WS_WgT + al256((size_t)2 * 2048 * 1024 * 2);
constexpr size_t WS_WpsT = WS_WgluT + al256((size_t)2 * 512 * 512 * 2);
constexpr size_t WS_WpaT = WS_WpsT + al256((size_t)2 * 1024 * 512 * 2);
constexpr size_t WS_WoT = WS_WpaT + al256((size_t)2 * 1024 * 512 * 2);
constexpr size_t WS_mod = WS_WoT + al256((size_t)2 * 1024 * 1024 * 2);
constexpr size_t WS_ab = WS_mod + al256((size_t)2 * 24 * 3072 * 4);
constexpr size_t WS_Bmat = WS_ab + al256((size_t)2 * 32 * 64 * 2 * 4);
constexpr size_t WS_Cmat = WS_Bmat + al256((size_t)2 * 32 * 128 * 16 * 2);
constexpr size_t WS_H = WS_Cmat + al256((size_t)2 * 32 * 16 * 128 * 2);
constexpr size_t WS_U = WS_H + al256((size_t)NTOK * 1024 * 2);
constexpr size_t WS_QI = WS_U + (size_t)NTOK * 512 * 2;
constexpr size_t WS_ZS = WS_QI + al256((size_t)NTOK * 512 * 2);
constexpr size_t WS_Q = WS_ZS + al256((size_t)NTOK * 512 * 2);
constexpr size_t WS_ZA = WS_Q + al256((size_t)NTOK * 512 * 2);
constexpr size_t WS_Kp = WS_ZA + al256((size_t)NTOK * 512 * 2);
constexpr size_t WS_VTp = WS_Kp + al256((size_t)NP * 512 * 2);
constexpr size_t WS_KIp = WS_VTp + al256((size_t)NP * 512 * 2);
constexpr size_t WS_Ks = WS_KIp + al256((size_t)NP * 64 * 2);
constexpr size_t WS_VTs = WS_Ks + al256((size_t)16 * KS_ROWS * 512 * 2);
constexpr size_t WS_KIs = WS_VTs + al256((size_t)16 * 512 * KS_ROWS * 2);
constexpr size_t WS_WI = WS_KIs + al256((size_t)16 * KIS_ROWS * 64 * 2);
constexpr size_t WS_SlocR = WS_WI + al256((size_t)NTOK * 8 * 4);
constexpr size_t WS_SlocI = WS_SlocR + al256((size_t)8 * 128 * 32 * 64 * 4);
constexpr size_t WS_HstR = WS_SlocI + al256((size_t)8 * 128 * 32 * 64 * 4);
constexpr size_t WS_HstI = WS_HstR + al256((size_t)8 * 128 * 32 * 64 * 4);
constexpr size_t WS_maskp = WS_HstI + al256((size_t)8 * 128 * 32 * 64 * 4);
constexpr size_t WS_masks = WS_maskp + al256((size_t)NP * 512 * 2);
constexpr size_t WS_BbF = WS_masks + al256((size_t)NS * MS_ROW * 2);
constexpr size_t WS_TOTAL = WS_BbF + al256((size_t)64 * 2 * 16 * 64 * 4);

DI u16 f2bf(float x) { uint32_t u = __float_as_uint(x); u += 0x7fffu + ((u >> 16) & 1u); return (u16)(u >> 16); }
DI float bf2f(u16 h) { return __uint_as_float(((uint32_t)h) << 16); }
DI uint32_t pack2(float a, float b) { return (uint32_t)f2bf(a) | ((uint32_t)f2bf(b) << 16); }
DI float sigmoidf_(float x) { return 1.f / (1.f + __expf(-x)); }
DI float siluf_(float x) { return x * sigmoidf_(x); }
DI float geluf_(float v) { return v * sigmoidf_(1.5957691216f * (v + 0.044715f * v * v * v)); }
DI float wave_sum(float v) {
#pragma unroll
  for (int o = 32; o > 0; o >>= 1) v += __shfl_xor(v, o);
  return v;
}
DI int tidx() { int t = threadIdx.x; asm volatile("" : "+v"(t)); return t; }
DI void wave_lds_sync() { asm volatile("s_waitcnt lgkmcnt(0)" ::: "memory"); }
DI f32x4 mfma16(bf16x8 a, bf16x8 b, f32x4 c) { return __builtin_amdgcn_mfma_f32_16x16x32_bf16(a, b, c, 0, 0, 0); }
typedef _Float16 f16x8 __attribute__((ext_vector_type(8)));
DI f32x4 mfma16h(bf16x8 a, bf16x8 b, f32x4 c) { return __builtin_amdgcn_mfma_f32_16x16x32_f16(__builtin_bit_cast(f16x8, a), __builtin_bit_cast(f16x8, b), c, 0, 0, 0); }
DI u16 f2h(float x) { const _Float16 h = (_Float16)x; return __builtin_bit_cast(u16, h); }
DI uint32_t pack2h(float a, float b) { return (uint32_t)f2h(a) | ((uint32_t)f2h(b) << 16); }
DI bf16x8 ldg8(const u16* p) { return *reinterpret_cast<const bf16x8*>(p); }
DI bf16x8 zero8() { bf16x8 z = {0, 0, 0, 0, 0, 0, 0, 0}; return z; }

DI const float* xin_row(const Params& p, int l, int R) {
  if (l == 0) return R < NP ? p.x_prompt + (size_t)R * 1024 : p.x_sample + (size_t)(R - NP) * 1024;
  return p.out + (size_t)R * 1024;
}
DI int batch_of(int R) { return R < NP ? (R >> 13) : 8 + ((R - NP) >> 5); }

template <int NT, bool F16 = false>
DI void gemm_accum(f32x4 (&acc)[4][NT], const u16* __restrict__ A, int lda, const u16* __restrict__ Bt, int ldb, int K, u16* lds) {
  constexpr int LR = 72;
  constexpr int BN = 32 * NT;
  constexpr int NBCH = BN / 32;
  constexpr int BUF = 256 * LR;
  const int tid = tidx(), lane = tid & 63, wave = tid >> 6, wr = wave >> 1, wc = wave & 1, fr = lane & 15, fq = lane >> 4;
  u32x4 ra[4], rb[NBCH];
  const int crow = tid >> 3, cch = tid & 7;
  const u16* Ap = A + (size_t)crow * lda + cch * 8;
  const u16* Bp = Bt + (size_t)crow * ldb + cch * 8;
  const int nk = K >> 6;
  auto gload = [&](int kt) {
    const int k0 = kt << 6;
#pragma unroll
    for (int i = 0; i < 4; ++i) ra[i] = *reinterpret_cast<const u32x4*>(Ap + (size_t)(i * 32) * lda + k0);
#pragma unroll
    for (int i = 0; i < NBCH; ++i) rb[i] = *reinterpret_cast<const u32x4*>(Bp + (size_t)(i * 32) * ldb + k0);
  };
  auto lstore = [&](int buf) {
    u16* sA = lds + buf * BUF;
    u16* sB = sA + 128 * LR;
#pragma unroll
    for (int i = 0; i < 4; ++i) *reinterpret_cast<u32x4*>(sA + (crow + i * 32) * LR + cch * 8) = ra[i];
#pragma unroll
    for (int i = 0; i < NBCH; ++i) *reinterpret_cast<u32x4*>(sB + (crow + i * 32) * LR + cch * 8) = rb[i];
  };
  gload(0);
  __syncthreads();
  lstore(0);
  if (nk > 1) gload(1);
  __syncthreads();
  for (int kt = 0; kt < nk; ++kt) {
    const int cur = kt & 1;
    if (kt + 1 < nk) lstore(cur ^ 1);
    if (kt + 2 < nk) gload(kt + 2);
    const u16* sA = lds + cur * BUF;
    const u16* sB = sA + 128 * LR;
#pragma unroll
    for (int ks = 0; ks < 2; ++ks) {
      bf16x8 a[4], b[NT];
#pragma unroll
      for (int m = 0; m < 4; ++m) a[m] = *reinterpret_cast<const bf16x8*>(sA + (wr * 64 + m * 16 + fr) * LR + ks * 32 + fq * 8);
#pragma unroll
      for (int n = 0; n < NT; ++n) b[n] = *reinterpret_cast<const bf16x8*>(sB + (wc * 16 * NT + n * 16 + fr) * LR + ks * 32 + fq * 8);
#pragma unroll
      for (int m = 0; m < 4; ++m)
#pragma unroll
        for (int n = 0; n < NT; ++n) acc[m][n] = F16 ? mfma16h(a[m], b[n], acc[m][n]) : mfma16(a[m], b[n], acc[m][n]);
    }
    __syncthreads();
  }
}
template <int NT>
DI void zero_acc(f32x4 (&acc)[4][NT]) {
#pragma unroll
  for (int m = 0; m < 4; ++m)
#pragma unroll
    for (int n = 0; n < NT; ++n) acc[m][n] = f32x4{0.f, 0.f, 0.f, 0.f};
}


struct GemmOrder {
  int x, j, nb, cnt, NN, k;
  DI void init(int nM, int NN_) { x = blockIdx.x & 7; j = blockIdx.x >> 3; nb = gridDim.x >> 3; cnt = (nM - x + 7) >> 3; NN = NN_; k = 0; }
  DI bool next(int& mt, int& nt) {
    for (;;) {
      const int s = j + nb * k; ++k;
      const int g = s / (4 * NN), r = s - g * (4 * NN);
      if (g * 4 >= cnt) return false;
      const int i = g * 4 + (r & 3);
      if (i >= cnt) continue;
      mt = x + 8 * i; nt = r >> 2; return true;
    }
  }
};
template <bool F16>
DI void transpose_w(const float* __restrict__ W, int K, int N, int n0, int ncount, u16* __restrict__ WT, int gtid, int gstride) {
  const int total = ncount * (K >> 3);
  for (int idx = gtid; idx < total; idx += gstride) {
    const int n = idx % ncount, kb = idx / ncount;
    const float* src = W + (size_t)(kb * 8) * N + n0 + n;
    float f[8];
#pragma unroll
    for (int j = 0; j < 8; ++j) f[j] = src[(size_t)j * N];
    uint4 o;
    if (F16) { o.x = pack2h(f[0], f[1]); o.y = pack2h(f[2], f[3]); o.z = pack2h(f[4], f[5]); o.w = pack2h(f[6], f[7]); }
    else { o.x = pack2(f[0], f[1]); o.y = pack2(f[2], f[3]); o.z = pack2(f[4], f[5]); o.w = pack2(f[6], f[7]); }
    *reinterpret_cast<uint4*>(WT + (size_t)n * K + kb * 8) = o;
  }
}

__device__ void phase_prep(const Params& p, char* lds) {
  const int gtid = blockIdx.x * 256 + tidx(), gstride = gridDim.x * 256;
  for (int l = 0; l < 2; ++l) {
    transpose_w<true>(p.w_in + (size_t)l * 1024 * D_IN, 1024, D_IN, 0, N_IN1, ((u16*)(p.ws + WS_WinT)) + (size_t)l * N_IN1P * 1024, gtid, gstride);
    transpose_w<true>(p.w_in + (size_t)l * 1024 * D_IN, 1024, D_IN, N_IN1, 2048, ((u16*)(p.ws + WS_WgT)) + (size_t)l * 2048 * 1024, gtid, gstride);
    transpose_w<false>(p.w_glu + (size_t)l * 512 * 512, 512, 512, 0, 512, ((u16*)(p.ws + WS_WgluT)) + (size_t)l * 512 * 512, gtid, gstride);
    transpose_w<false>(p.w_ps + (size_t)l * 512 * 1024, 512, 1024, 0, 1024, ((u16*)(p.ws + WS_WpsT)) + (size_t)l * 1024 * 512, gtid, gstride);
    transpose_w<false>(p.w_pa + (size_t)l * 512 * 1024, 512, 1024, 0, 1024, ((u16*)(p.ws + WS_WpaT)) + (size_t)l * 1024 * 512, gtid, gstride);
    transpose_w<false>(p.w_o + (size_t)l * 1024 * 1024, 1024, 1024, 0, 1024, ((u16*)(p.ws + WS_WoT)) + (size_t)l * 1024 * 1024, gtid, gstride);
  }
  for (int idx = gtid; idx < 2 * 32 * 64; idx += gstride) {
    const int lg = idx >> 6, pp = idx & 63;
    const float are = p.a_re[idx], aim = p.a_im[idx];
    const float dt = expf(p.log_dt[lg]);
    const float mag = expf(are * dt), ang = aim * dt;
    const float kk = rintf(ang * 0.15915494309189535f);
    float r = fmaf(-kk, 6.2831854820251465f, ang);
    r = fmaf(-kk, -1.7484556e-07f, r);
    const float cs = cosf(r), sn = sinf(r);
    const float abr = mag * cs, abi = mag * sn;
    const float den = are * are + aim * aim;
    const float nr = abr - 1.f, ni = abi;
    const float fre = (nr * are + ni * aim) / den, fim = (ni * are - nr * aim) / den;
    ((float*)(p.ws + WS_ab))[idx * 2] = abr; ((float*)(p.ws + WS_ab))[idx * 2 + 1] = abi;
#pragma unroll
    for (int n = 0; n < 16; ++n) {
      const float br = p.b_re[(size_t)idx * 16 + n], bi = p.b_im[(size_t)idx * 16 + n];
      ((float*)(p.ws + WS_BbF))[(((size_t)lg * 2 + 0) * 16 + n) * 64 + pp] = fre * br - fim * bi;
      ((float*)(p.ws + WS_BbF))[(((size_t)lg * 2 + 1) * 16 + n) * 64 + pp] = fre * bi + fim * br;
      ((u16*)(p.ws + WS_Bmat))[((size_t)lg * 128 + pp) * 16 + n] = f2bf(fre * br - fim * bi);
      ((u16*)(p.ws + WS_Bmat))[((size_t)lg * 128 + 64 + pp) * 16 + n] = f2bf(fre * bi + fim * br);
      ((u16*)(p.ws + WS_Cmat))[((size_t)lg * 16 + n) * 128 + pp] = f2bf(p.c_re[((size_t)lg * 16 + n) * 64 + pp]);
      ((u16*)(p.ws + WS_Cmat))[((size_t)lg * 16 + n) * 128 + 64 + pp] = f2bf(-p.c_im[((size_t)lg * 16 + n) * 64 + pp]);
    }
  }
  float* red = reinterpret_cast<float*>(lds);
  for (int u = blockIdx.x; u < 192; u += gridDim.x) {
    const int l = u / 96, cg_ = u % 96;
    const int col = tidx() & 31, ks = tidx() >> 5;
    float acc[24];
#pragma unroll
    for (int r = 0; r < 24; ++r) acc[r] = 0.f;
    const float* wm = p.w_mod + (size_t)l * 1024 * 3072 + cg_ * 32 + col;
    for (int k = ks * 128; k < ks * 128 + 128; ++k) {
      const float w = wm[(size_t)k * 3072];
#pragma unroll
      for (int r = 0; r < 24; ++r) {
        const float c = r < 8 ? p.c_prompt[r * 1024 + k] : p.c_sample[(r - 8) * 1024 + k];
        acc[r] = fmaf(siluf_(c), w, acc[r]);
      }
    }
    __syncthreads();
#pragma unroll
    for (int r = 0; r < 24; ++r) red[(ks * 24 + r) * 32 + col] = acc[r];
    __syncthreads();
    for (int o = tidx(); o < 768; o += 256) {
      const int r = o >> 5, c = o & 31;
      float s = p.b_mod[l * 3072 + cg_ * 32 + c];
#pragma unroll
      for (int k8 = 0; k8 < 8; ++k8) s += red[(k8 * 24 + r) * 32 + c];
      ((float*)(p.ws + WS_mod))[((size_t)l * 24 + r) * 3072 + cg_ * 32 + c] = s;
    }
  }
}

__device__ void phase_norm(const Params& p, int l) {
  const int wave = tidx() >> 6, lane = tidx() & 63;
  const int gw = blockIdx.x * 4 + wave, nw = gridDim.x * 4;
  const float* gn = p.g_norm + l * 1024;
  for (int R = gw; R < NTOK; R += nw) {
    const float* x = xin_row(p, l, R);
    float4 v[4];
    float ss = 0.f;
#pragma unroll
    for (int i = 0; i < 4; ++i) {
      v[i] = *reinterpret_cast<const float4*>(x + i * 256 + lane * 4);
      ss += v[i].x * v[i].x + v[i].y * v[i].y + v[i].z * v[i].z + v[i].w * v[i].w;
    }
    ss = wave_sum(ss);
    const float rstd = rsqrtf(ss * (1.f / 1024.f) + 1e-6f);
    const float* md = ((float*)(p.ws + WS_mod)) + ((size_t)l * 24 + batch_of(R)) * 3072;
#pragma unroll
    for (int i = 0; i < 4; ++i) {
      const int c = i * 256 + lane * 4;
      const float4 g4 = *reinterpret_cast<const float4*>(gn + c);
      const float4 sh = *reinterpret_cast<const float4*>(md + c);
      const float4 sc = *reinterpret_cast<const float4*>(md + 1024 + c);
      uint2 o;
      o.x = pack2h(v[i].x * rstd * g4.x * (1.f + sc.x) + sh.x, v[i].y * rstd * g4.y * (1.f + sc.y) + sh.y);
      o.y = pack2h(v[i].z * rstd * g4.z * (1.f + sc.z) + sh.z, v[i].w * rstd * g4.w * (1.f + sc.w) + sh.w);
      *reinterpret_cast<uint2*>(((u16*)(p.ws + WS_H)) + (size_t)R * 1024 + c) = o;
    }
  }
  const int gtid = blockIdx.x * 256 + tidx(), gstride = gridDim.x * 256;
  {
    const float* ck = p.cache_k + (size_t)l * 16 * 4096 * 512;
    for (int idx = gtid; idx < 16 * 4096 * 512 / 8; idx += gstride) {
      const size_t e = (size_t)idx * 8;
      const int b = (int)(e / (4096 * 512)), rem = (int)(e % (4096 * 512));
      const float4 a = *reinterpret_cast<const float4*>(ck + e), c = *reinterpret_cast<const float4*>(ck + e + 4);
      uint4 o; o.x = pack2(a.x, a.y); o.y = pack2(a.z, a.w); o.z = pack2(c.x, c.y); o.w = pack2(c.z, c.w);
      *reinterpret_cast<uint4*>(((u16*)(p.ws + WS_Ks)) + (size_t)b * KS_ROWS * 512 + rem) = o;
    }
    const float* cki = p.cache_kidx + (size_t)l * 16 * 4096 * 64;
    for (int idx = gtid; idx < 16 * 4096 * 64 / 8; idx += gstride) {
      const size_t e = (size_t)idx * 8;
      const int b = (int)(e / (4096 * 64)), rem = (int)(e % (4096 * 64));
      const float4 a = *reinterpret_cast<const float4*>(cki + e), c = *reinterpret_cast<const float4*>(cki + e + 4);
      uint4 o; o.x = pack2h(a.x, a.y); o.y = pack2h(a.z, a.w); o.z = pack2h(c.x, c.y); o.w = pack2h(c.z, c.w);
      *reinterpret_cast<uint4*>(((u16*)(p.ws + WS_KIs)) + (size_t)b * KIS_ROWS * 64 + rem) = o;
    }
    const float* cv = p.cache_v + (size_t)l * 16 * 4096 * 512;
    for (int idx = gtid; idx < 16 * 512 * 512; idx += gstride) {
      const int c = idx & 511, sb = (idx >> 9) & 511, b = idx >> 18;
      const float* src = cv + ((size_t)b * 4096 + sb * 8) * 512 + c;
      float f[8];
#pragma unroll
      for (int j = 0; j < 8; ++j) f[j] = src[(size_t)j * 512];
      uint4 o; o.x = pack2(f[0], f[1]); o.y = pack2(f[2], f[3]); o.z = pack2(f[4], f[5]); o.w = pack2(f[6], f[7]);
      *reinterpret_cast<uint4*>(((u16*)(p.ws + WS_VTs)) + ((size_t)b * 512 + c) * KS_ROWS + sb * 8) = o;
    }
  }
}

__device__ void phase_inproj(const Params& p, int l, char* lds) {
  const int lane = tidx() & 63, wave = tidx() >> 6, wr = wave >> 1, wc = wave & 1, fr = lane & 15, fq = lane >> 4;
  GemmOrder ord; ord.init(NTOK / 128, 29);
  int mt, nt;
  while (ord.next(mt, nt)) {
    f32x4 acc[4][4];
    zero_acc<4>(acc);
    gemm_accum<4, true>(acc, ((u16*)(p.ws + WS_H)) + (size_t)mt * 128 * 1024, 1024, ((u16*)(p.ws + WS_WinT)) + ((size_t)l * N_IN1P + nt * 128) * 1024, 1024, 1024, reinterpret_cast<u16*>(lds));
    const int region = nt >> 2;
#pragma unroll
    for (int m = 0; m < 4; ++m) {
      const int R0 = mt * 128 + wr * 64 + m * 16 + fq * 4;
      const bool smp = R0 >= NP;
      const int rs = R0 - NP;
      const int b = smp ? (rs >> 5) : (R0 >> 13);
      const int s0 = smp ? (rs & 31) : (R0 & 8191);
#pragma unroll
      for (int n = 0; n < 4; ++n) {
        const int C = nt * 128 + wc * 64 + n * 16 + fr;
        const f32x4 v = acc[m][n];
        if (region == 0) {
#pragma unroll
          for (int j = 0; j < 4; ++j) ((u16*)(p.ws + WS_U))[(size_t)(R0 + j) * 512 + C] = f2bf(v[j]);
        } else if (region == 1) {
#pragma unroll
          for (int j = 0; j < 4; ++j) ((u16*)(p.ws + WS_ZS))[(size_t)(R0 + j) * 512 + (C - 512)] = f2bf(siluf_(v[j]));
        } else if (region == 2) {
#pragma unroll
          for (int j = 0; j < 4; ++j) ((u16*)(p.ws + WS_Q))[(size_t)(R0 + j) * 512 + (C - 1024)] = f2bf(v[j] * 0.18033688011112042f);
        } else if (region == 3) {
          const int cc = C - 1536;
          float* of = smp ? p.out + O_KS + (size_t)l * 262144 + (size_t)rs * 512 + cc : p.out + O_KP + (size_t)l * 33554432 + (size_t)R0 * 512 + cc;
          u16* ob = smp ? ((u16*)(p.ws + WS_Ks)) + ((size_t)b * KS_ROWS + 4096 + s0) * 512 + cc : ((u16*)(p.ws + WS_Kp)) + (size_t)R0 * 512 + cc;
#pragma unroll
          for (int j = 0; j < 4; ++j) { of[(size_t)j * 512] = v[j]; ob[(size_t)j * 512] = f2bf(v[j]); }
        } else if (region == 4) {
          const int cc = C - 2048;
          float* of = smp ? p.out + O_VS + (size_t)l * 262144 + (size_t)rs * 512 + cc : p.out + O_VP + (size_t)l * 33554432 + (size_t)R0 * 512 + cc;
#pragma unroll
          for (int j = 0; j < 4; ++j) of[(size_t)j * 512] = v[j];
          uint2 o; o.x = pack2(v[0], v[1]); o.y = pack2(v[2], v[3]);
          u16* ob = smp ? ((u16*)(p.ws + WS_VTs)) + ((size_t)b * 512 + cc) * KS_ROWS + 4096 + s0 : ((u16*)(p.ws + WS_VTp)) + ((size_t)b * 512 + cc) * 8192 + s0;
          *reinterpret_cast<uint2*>(ob) = o;
        } else if (region == 5) {
#pragma unroll
          for (int j = 0; j < 4; ++j) ((u16*)(p.ws + WS_ZA))[(size_t)(R0 + j) * 512 + (C - 2560)] = f2bf(siluf_(v[j]));
        } else if (region == 6) {
#pragma unroll
          for (int j = 0; j < 4; ++j) ((u16*)(p.ws + WS_QI))[(size_t)(R0 + j) * 512 + (C - 3072)] = f2h(v[j] * 0.125f);
        } else {
          if (C < 3648) {
            const int cc = C - 3584;
            float* of = smp ? p.out + O_KIS + (size_t)l * 32768 + (size_t)rs * 64 + cc : p.out + O_KIP + (size_t)l * 4194304 + (size_t)R0 * 64 + cc;
            u16* ob = smp ? ((u16*)(p.ws + WS_KIs)) + ((size_t)b * KIS_ROWS + 4096 + s0) * 64 + cc : ((u16*)(p.ws + WS_KIp)) + (size_t)R0 * 64 + cc;
#pragma unroll
            for (int j = 0; j < 4; ++j) { of[(size_t)j * 64] = v[j]; ob[(size_t)j * 64] = f2h(v[j]); }
          } else if (C < 3656) {
#pragma unroll
            for (int j = 0; j < 4; ++j) ((float*)(p.ws + WS_WI))[(size_t)(R0 + j) * 8 + (C - 3648)] = v[j] * 0.35355339059327373f;
          }
        }
      }
    }
  }
}

DI void ssm_unit(const Params& p, int l, int g, int row0, int T, float& hr, float& hi, bool write_y, u16* tile) {
  const int lane = tidx() & 63, fr = lane & 15, fq = lane >> 4;
  const int lg = l * 32 + g;
  const float abr = ((float*)(p.ws + WS_ab))[((size_t)lg * 64 + lane) * 2], abi = ((float*)(p.ws + WS_ab))[((size_t)lg * 64 + lane) * 2 + 1];
  const int ntile = T >> 4;
  bf16x8 am[8];
#pragma unroll
  for (int mt = 0; mt < 8; ++mt) am[mt] = fq < 2 ? ldg8(((u16*)(p.ws + WS_Bmat)) + ((size_t)lg * 128 + mt * 16 + fr) * 16 + fq * 8) : zero8();
  bf16x8 bu4[4];
#pragma unroll
  for (int nt = 0; nt < 4; ++nt) bu4[nt] = (fq < 2 && nt < ntile) ? ldg8(((u16*)(p.ws + WS_U)) + (size_t)(row0 + nt * 16 + fr) * 512 + g * 16 + fq * 8) : zero8();
#pragma unroll
  for (int nt = 0; nt < 4; ++nt) {
    if (nt >= ntile) break;
    const bf16x8 bu = bu4[nt];
#pragma unroll
    for (int mt = 0; mt < 8; ++mt) {
      const f32x4 a = mfma16(am[mt], bu, f32x4{0.f, 0.f, 0.f, 0.f});
      uint2 o; o.x = pack2(a[0], a[1]); o.y = pack2(a[2], a[3]);
      *reinterpret_cast<uint2*>(tile + (nt * 16 + fr) * 136 + mt * 16 + fq * 4) = o;
    }
  }
  wave_lds_sync();
  for (int t = 0; t < T; ++t) {
    const float br = bf2f(tile[t * 136 + lane]), bi = bf2f(tile[t * 136 + 64 + lane]);
    const float nhr = fmaf(abr, hr, fmaf(-abi, hi, br));
    const float nhi = fmaf(abr, hi, fmaf(abi, hr, bi));
    hr = nhr; hi = nhi;
    if (write_y) { tile[t * 136 + lane] = f2bf(hr); tile[t * 136 + 64 + lane] = f2bf(hi); }
  }
  if (!write_y) return;
  wave_lds_sync();
  bf16x8 cm[4];
#pragma unroll
  for (int ks = 0; ks < 4; ++ks) cm[ks] = ldg8(((u16*)(p.ws + WS_Cmat)) + ((size_t)lg * 16 + fr) * 128 + ks * 32 + fq * 8);
  const float dsk = p.d_skip[(size_t)lg * 16 + fr];
  u16 uv[4][4];
#pragma unroll
  for (int mt = 0; mt < 4; ++mt)
#pragma unroll
    for (int j = 0; j < 4; ++j) uv[mt][j] = mt < ntile ? ((u16*)(p.ws + WS_U))[(size_t)(row0 + mt * 16 + fq * 4 + j) * 512 + g * 16 + fr] : (u16)0;
  f32x4 ya[4];
#pragma unroll
  for (int mt = 0; mt < 4; ++mt) {
    f32x4 a = {0.f, 0.f, 0.f, 0.f};
    if (mt < ntile) {
#pragma unroll
      for (int ks = 0; ks < 4; ++ks) a = mfma16(*reinterpret_cast<const bf16x8*>(tile + (mt * 16 + fr) * 136 + ks * 32 + fq * 8), cm[ks], a);
    }
    ya[mt] = a;
  }
#pragma unroll
  for (int mt = 0; mt < 4; ++mt) {
    if (mt < ntile) {
#pragma unroll
      for (int j = 0; j < 4; ++j) {
        u16* up = ((u16*)(p.ws + WS_U)) + (size_t)(row0 + mt * 16 + fq * 4 + j) * 512 + g * 16 + fr;
        const float y = ya[mt][j] + dsk * bf2f(uv[mt][j]);
        *up = f2bf(geluf_(y));
      }
    }
  }
  wave_lds_sync();
}

__device__ void indexer_unit(const Params& p, bool smp, int b, int q0, int nkeys, char* lds) {
  const int tid = tidx(), lane = tid & 63, wave = tid >> 6, fr = lane & 15, fq = lane >> 4;
  constexpr int HROW = 1025;
  uint32_t* hist = reinterpret_cast<uint32_t*>(lds);
  u16* maskbuf = reinterpret_cast<u16*>(lds);
  constexpr int CAP0 = 512;
  uint32_t* candK = reinterpret_cast<uint32_t*>(lds + 16640);
  u16* candP = reinterpret_cast<u16*>(lds + 16640 + 16 * CAP0 * 4);
  uint32_t* s_pref = reinterpret_cast<uint32_t*>(lds + 65792);
  uint32_t* s_need = s_pref + 16;
  uint32_t* s_cnt = s_need + 16;
  uint32_t* s_cn = s_cnt + 16;
  uint32_t* s_flag = s_cn + 16;
  uint32_t* s_cand = s_flag + 16;
  constexpr int CAP = 16;
  constexpr int MB = 520;
  const int Rq0 = smp ? NP + b * 32 + q0 : b * 8192 + q0;
  const u16* KI = smp ? ((u16*)(p.ws + WS_KIs)) + (size_t)b * KIS_ROWS * 64 : ((u16*)(p.ws + WS_KIp)) + (size_t)b * 8192 * 64;
  const int ntiles = nkeys >> 4;

  bf16x8 aq[8][2];
#pragma unroll
  for (int h = 0; h < 8; ++h)
#pragma unroll
    for (int ks = 0; ks < 2; ++ks) aq[h][ks] = ldg8(((u16*)(p.ws + WS_QI)) + (size_t)(Rq0 + fr) * 512 + h * 64 + ks * 32 + fq * 8);
  float w[8];
#pragma unroll
  for (int h = 0; h < 8; ++h) w[h] = ((float*)(p.ws + WS_WI))[(size_t)(Rq0 + fr) * 8 + h];

  bf16x8 nb0 = zero8(), nb1 = zero8();
  auto load_keys = [&](int kt) {
    const u16* kp = KI + (size_t)(kt * 16 + fr) * 64 + fq * 8;
    nb0 = ldg8(kp); nb1 = ldg8(kp + 32);
  };
  auto score_keys = [&](int kt, uint32_t (&key)[4]) {
    const bf16x8 b0 = nb0, b1 = nb1;
    if (kt + 4 < ntiles) load_keys(kt + 4);
    float sc[4] = {0.f, 0.f, 0.f, 0.f};
#pragma unroll
    for (int h = 0; h < 8; ++h) {
      f32x4 a = mfma16h(b0, aq[h][0], f32x4{0.f, 0.f, 0.f, 0.f});
      a = mfma16h(b1, aq[h][1], a);
#pragma unroll
      for (int j = 0; j < 4; ++j) sc[j] = fmaf(w[h], __builtin_amdgcn_fmed3f(a[j], 0.f, 3.0e38f), sc[j]);
    }
#pragma unroll
    for (int j = 0; j < 4; ++j) {
      const uint32_t uu = __float_as_uint(sc[j]);
      key[j] = (uu & 0x80000000u) ? ~uu : (uu | 0x80000000u);
    }
  };

  __syncthreads();
  if (tid < 16) { s_pref[tid] = 0u; s_need[tid] = 256u; s_cn[tid] = 0u; if (tid == 0) { s_flag[0] = 0u; s_flag[1] = 0u; } }
  if (nkeys > 256) {
#pragma unroll 1
    for (int pass = 0; pass < 3; ++pass) {
      if (pass == 1 && s_flag[1] == 0u) break;
      if (pass == 2 && s_flag[0] == 0u) break;
      for (int i = tid; i < 16 * HROW / 4; i += 256) reinterpret_cast<uint4*>(hist)[i] = uint4{0u, 0u, 0u, 0u};
      __syncthreads();
      const uint32_t pref = s_pref[fr];
      const int mshift = pass == 0 ? 32 : (pass == 1 ? 21 : 10);
      const int bshift = pass == 0 ? 21 : (pass == 1 ? 10 : 0);
      const uint32_t bmask = pass == 2 ? 1023u : 2047u;
      if (wave < ntiles) load_keys(wave);
      for (int kt = wave; kt < ntiles; kt += 4) {
        uint32_t key[4];
        score_keys(kt, key);
#pragma unroll
        for (int j = 0; j < 4; ++j) {
          const bool match = pass == 0 ? true : ((key[j] >> mshift) == pref);
          if (match) {
            const uint32_t bin = (key[j] >> bshift) & bmask;
            atomicAdd(&hist[fr * HROW + (bin >> 1)], (bin & 1u) ? 0x10000u : 1u);
          }
        }
      }
      __syncthreads();
      {
        const int q = tid >> 4, part = tid & 15;
        const int nb = pass == 2 ? 1024 : 2048;
        const int per = nb >> 4;
        const uint32_t* hq = hist + q * HROW;
        uint32_t mysum = 0;
        for (int wd = (part * per) >> 1; wd < ((part + 1) * per) >> 1; ++wd) { const uint32_t x = hq[wd]; mysum += (x & 0xffffu) + (x >> 16); }
        uint32_t v = mysum;
#pragma unroll
        for (int d = 1; d < 16; d <<= 1) { const uint32_t t2 = __shfl_down(v, d, 16); if (part + d < 16) v += t2; }
        const uint32_t above = v - mysum;
        const uint32_t need = s_need[q];
        const uint32_t prefq = s_pref[q];
        __syncthreads();
        if (above < need && need <= above + mysum) {
          uint32_t c = above;
          for (int bin = (part + 1) * per - 1; bin >= part * per; --bin) {
            const uint32_t cnt = (hq[bin >> 1] >> ((bin & 1) * 16)) & 0xffffu;
            if (c + cnt >= need) {
              s_pref[q] = (prefq << (pass == 2 ? 10 : 11)) | (uint32_t)bin;
              s_need[q] = need - c;
              if (pass == 1) { s_cnt[q] = cnt; if (cnt > (uint32_t)CAP) s_flag[0] = 1u; }
              if (pass == 0 && cnt > (uint32_t)CAP0) s_flag[1] = 1u;
              break;
            }
            c += cnt;
          }
        }
        __syncthreads();
      }
    }
  } else {
    __syncthreads();
  }
  const bool fast0 = (nkeys > 256) && (s_flag[1] == 0u);
  const bool fast = (nkeys > 256) && !fast0 && (s_flag[0] == 0u);
  const uint32_t thr = s_pref[fr];
  __syncthreads();
  const int nw16 = smp ? 260 : ntiles;
  if (wave < ntiles) load_keys(wave);
  for (int kt = wave; kt < nw16; kt += 4) {
    uint32_t word = 0;
    if (kt < ntiles) {
      uint32_t key[4];
      score_keys(kt, key);
      if (fast0) {
#pragma unroll
        for (int j = 0; j < 4; ++j) {
          const uint32_t k11 = key[j] >> 21;
          word |= (k11 > thr ? 1u : 0u) << (fq * 4 + j);
          if (k11 == thr) {
            const uint32_t ci = atomicAdd(&s_cn[fr], 1u);
            if (ci < (uint32_t)CAP0) { candK[fr * CAP0 + ci] = key[j] & 0x1fffffu; candP[fr * CAP0 + ci] = (u16)(kt * 16 + fq * 4 + j); }
          }
        }
      } else if (fast) {
#pragma unroll
        for (int j = 0; j < 4; ++j) {
          const uint32_t k22 = key[j] >> 10;
          word |= (k22 > thr ? 1u : 0u) << (fq * 4 + j);
          if (k22 == thr) {
            const uint32_t ci = atomicAdd(&s_cn[fr], 1u);
            if (ci < (uint32_t)CAP) s_cand[fr * CAP + ci] = (key[j] & 1023u) | ((uint32_t)(kt * 16 + fq * 4 + j) << 10);
          }
        }
      } else {
#pragma unroll
        for (int j = 0; j < 4; ++j) word |= (key[j] >= thr ? 1u : 0u) << (fq * 4 + j);
      }
      word |= __shfl_xor(word, 16);
      word |= __shfl_xor(word, 32);
    }
    if (fq == 0) maskbuf[fr * MB + kt] = (u16)word;
  }
  __syncthreads();
  if (fast0) {
    const int q = tid >> 4, part = tid & 15;
    const uint32_t n = s_cn[q] < (uint32_t)CAP0 ? s_cn[q] : (uint32_t)CAP0, need = s_need[q];
    uint32_t T = 0;
    for (int bit = 20; bit >= 0; --bit) {
      const uint32_t trial = T | (1u << bit);
      uint32_t c = 0;
      for (uint32_t i = part; i < n; i += 16) c += (candK[q * CAP0 + i] >= trial) ? 1u : 0u;
      c += __shfl_xor(c, 1); c += __shfl_xor(c, 2); c += __shfl_xor(c, 4); c += __shfl_xor(c, 8);
      if (c >= need) T = trial;
    }
    for (uint32_t i = part; i < n; i += 16) {
      if (candK[q * CAP0 + i] >= T) {
        const uint32_t pos = candP[q * CAP0 + i];
        const uint32_t widx = (uint32_t)(q * MB) + (pos >> 4);
        atomicOr(reinterpret_cast<uint32_t*>(maskbuf) + (widx >> 1), (1u << (pos & 15u)) << ((widx & 1u) * 16u));
      }
    }
    __syncthreads();
  }
  if (fast) {
    if (tid < 16) {
      const uint32_t n = s_cn[tid] < (uint32_t)CAP ? s_cn[tid] : (uint32_t)CAP, need = s_need[tid];
      for (uint32_t i = 0; i < n; ++i) {
        const uint32_t ci = s_cand[tid * CAP + i], vi = ci & 1023u;
        uint32_t greater = 0;
        for (uint32_t k = 0; k < n; ++k) greater += ((s_cand[tid * CAP + k] & 1023u) > vi) ? 1u : 0u;
        if (greater < need) {
          const uint32_t pos = ci >> 10;
          maskbuf[tid * MB + (pos >> 4)] |= (u16)(1u << (pos & 15u));
        }
      }
    }
    __syncthreads();
  }
  {
    const int n8 = nw16 >> 2;
    for (int i = tid; i < 16 * n8; i += 256) {
      const int q = i / n8, c = i % n8;
      const uint2 vv = *reinterpret_cast<const uint2*>(maskbuf + q * MB + c * 4);
      u16* dst = smp ? ((u16*)(p.ws + WS_masks)) + (size_t)(b * 32 + q0 + q) * MS_ROW : ((u16*)(p.ws + WS_maskp)) + (size_t)(b * 8192 + q0 + q) * 512;
      *reinterpret_cast<uint2*>(dst + c * 4) = vv;
    }
  }
}

__device__ void ssm_local_scan(const Params& p, int l, int b, int c, int g) {
  const int lane = tidx() & 63;
  const int lg = l * 32 + g;
  const float abr = ((float*)(p.ws + WS_ab))[((size_t)lg * 64 + lane) * 2], abi = ((float*)(p.ws + WS_ab))[((size_t)lg * 64 + lane) * 2 + 1];
  float bbr[16], bbi[16];
#pragma unroll
  for (int n = 0; n < 16; ++n) {
    bbr[n] = ((float*)(p.ws + WS_BbF))[(((size_t)lg * 2 + 0) * 16 + n) * 64 + lane];
    bbi[n] = ((float*)(p.ws + WS_BbF))[(((size_t)lg * 2 + 1) * 16 + n) * 64 + lane];
  }
  float hr = 0.f, hi = 0.f;
  const u16* up = ((u16*)(p.ws + WS_U)) + ((size_t)b * 8192 + (size_t)c * 64) * 512 + g * 16;
  u32x4 cur[8], nxt[8];
#pragma unroll
  for (int k = 0; k < 4; ++k) {
    cur[2 * k] = *reinterpret_cast<const u32x4*>(up + (size_t)k * 512);
    cur[2 * k + 1] = *reinterpret_cast<const u32x4*>(up + (size_t)k * 512 + 8);
  }
  for (int t4 = 0; t4 < 16; ++t4) {
    if (t4 + 1 < 16) {
#pragma unroll
      for (int k = 0; k < 4; ++k) {
        nxt[2 * k] = *reinterpret_cast<const u32x4*>(up + (size_t)((t4 + 1) * 4 + k) * 512);
        nxt[2 * k + 1] = *reinterpret_cast<const u32x4*>(up + (size_t)((t4 + 1) * 4 + k) * 512 + 8);
      }
    }
#pragma unroll
    for (int k = 0; k < 4; ++k) {
      float br = 0.f, bi = 0.f;
#pragma unroll
      for (int h2 = 0; h2 < 2; ++h2) {
        const u32x4 w = cur[2 * k + h2];
#pragma unroll
        for (int d = 0; d < 4; ++d) {
          const float x0 = __uint_as_float(w[d] << 16), x1 = __uint_as_float(w[d] & 0xffff0000u);
          const int n = h2 * 8 + d * 2;
          br = fmaf(bbr[n], x0, br); bi = fmaf(bbi[n], x0, bi);
          br = fmaf(bbr[n + 1], x1, br); bi = fmaf(bbi[n + 1], x1, bi);
        }
      }
      const float nhr = fmaf(abr, hr, fmaf(-abi, hi, br));
      const float nhi = fmaf(abr, hi, fmaf(abi, hr, bi));
      hr = nhr; hi = nhi;
    }
#pragma unroll
    for (int k = 0; k < 8; ++k) cur[k] = nxt[k];
  }
  const size_t o = ((size_t)(b * 128 + c) * 32 + g) * 64 + lane;
  ((float*)(p.ws + WS_SlocR))[o] = hr; ((float*)(p.ws + WS_SlocI))[o] = hi;
}

__device__ void phase_ssmA_indexer(const Params& p, int l, char* lds) {
  const int wave = tidx() >> 6;
  const int x = blockIdx.x & 7, j = blockIdx.x >> 3, nb = gridDim.x >> 3;
  if (blockIdx.x < 32) indexer_unit(p, true, blockIdx.x >> 1, (blockIdx.x & 1) * 16, 4128, lds);
  for (int tlo = j; tlo < 256; tlo += nb) {
    const int th = 511 - tlo;
    indexer_unit(p, false, x, th * 16, ((th >> 2) + 1) * 64, lds);
    indexer_unit(p, false, x, tlo * 16, ((tlo >> 2) + 1) * 64, lds);
  }
  for (int u = blockIdx.x; u < 8192; u += gridDim.x) {
    const int wu = u * 4 + wave;
    ssm_local_scan(p, l, wu >> 12, (wu >> 5) & 127, wu & 31);
  }
}

DI bf16x8 pack8_bf16(float a0, float a1, float a2, float a3, float a4, float a5, float a6, float a7) {
  u32x4 r;
  asm("v_cvt_pk_bf16_f32 %0, %4, %5\n\tv_cvt_pk_bf16_f32 %1, %6, %7\n\tv_cvt_pk_bf16_f32 %2, %8, %9\n\tv_cvt_pk_bf16_f32 %3, %10, %11\n\ts_nop 1"
      : "=&v"(r[0]), "=&v"(r[1]), "=&v"(r[2]), "=&v"(r[3])
      : "v"(a0), "v"(a1), "v"(a2), "v"(a3), "v"(a4), "v"(a5), "v"(a6), "v"(a7));
  return __builtin_bit_cast(bf16x8, r);
}

__device__ void attn_unit(const Params& p, bool smp, int b, int chunk, int h, char* lds) {
  constexpr int LR = 72;
  constexpr int STG = 128 * LR;
  const int tid = tidx(), lane = tid & 63, wave = tid >> 6, fr = lane & 15, fq = lane >> 4;
  u16* sbase = reinterpret_cast<u16*>(lds);
  const int nq = smp ? 32 : 64;
  const int nkeys = smp ? 4128 : 64 * (chunk + 1);
  const int ntile = (nkeys + 63) >> 6;
  const int Rq0 = smp ? NP + b * 32 : b * 8192 + chunk * 64;
  const u16* Kb = (smp ? ((u16*)(p.ws + WS_Ks)) + (size_t)b * KS_ROWS * 512 : ((u16*)(p.ws + WS_Kp)) + (size_t)b * 8192 * 512) + h * 64;
  const int Sv = smp ? KS_ROWS : 8192;
  const u16* Vb = smp ? ((u16*)(p.ws + WS_VTs)) + ((size_t)b * 512 + h * 64) * KS_ROWS : ((u16*)(p.ws + WS_VTp)) + ((size_t)b * 512 + h * 64) * 8192;
  const bool active = wave * 16 < nq;
  const int qrow = active ? wave * 16 : 0;
  bf16x8 aq[2];
#pragma unroll
  for (int ks = 0; ks < 2; ++ks) aq[ks] = ldg8(((u16*)(p.ws + WS_Q)) + (size_t)(Rq0 + qrow + fr) * 512 + h * 64 + ks * 32 + fq * 8);
  const u16* mrow = smp ? ((u16*)(p.ws + WS_masks)) + (size_t)(b * 32 + qrow + fr) * MS_ROW
                        : ((u16*)(p.ws + WS_maskp)) + (size_t)(b * 8192 + chunk * 64 + qrow + fr) * 512;
  const int srow = tid >> 3, sch = tid & 7;
  u32x4 rk[2], rv[2];
  u32x2 mk;
  auto gload = [&](int kt) {
#pragma unroll
    for (int i = 0; i < 2; ++i) {
      rk[i] = *reinterpret_cast<const u32x4*>(Kb + (size_t)(kt * 64 + srow + i * 32) * 512 + sch * 8);
      rv[i] = *reinterpret_cast<const u32x4*>(Vb + (size_t)(srow + i * 32) * Sv + kt * 64 + sch * 8);
    }
    mk = *reinterpret_cast<const u32x2*>(mrow + kt * 4);
  };
  auto lstore = [&](int buf) {
    u16* sK = sbase + buf * STG;
    u16* sV = sK + 64 * LR;
#pragma unroll
    for (int i = 0; i < 2; ++i) {
      *reinterpret_cast<u32x4*>(sK + (srow + i * 32) * LR + sch * 8) = rk[i];
      *reinterpret_cast<u32x4*>(sV + (srow + i * 32) * LR + sch * 8) = rv[i];
    }
  };
  f32x4 Ot[4];
#pragma unroll
  for (int n = 0; n < 4; ++n) Ot[n] = f32x4{0.f, 0.f, 0.f, 0.f};
  float mrun = -1e29f, lrun = 0.f;
  gload(0);
  __syncthreads();
  lstore(0);
  u32x2 mcur = mk;
  if (ntile > 1) gload(1);
  __syncthreads();
  for (int kt = 0; kt < ntile; ++kt) {
    const int cur = kt & 1;
    const u32x2 mthis = mcur;
    if (kt + 1 < ntile) { lstore(cur ^ 1); mcur = mk; }
    if (kt + 2 < ntile) gload(kt + 2);
    if (active) {
      const u16* sK = sbase + cur * STG;
      const u16* sV = sK + 64 * LR;
      f32x4 st[4];
#pragma unroll
      for (int n = 0; n < 4; ++n) {
        f32x4 a = {0.f, 0.f, 0.f, 0.f};
#pragma unroll
        for (int ks = 0; ks < 2; ++ks) a = mfma16(*reinterpret_cast<const bf16x8*>(sK + (n * 16 + fr) * LR + ks * 32 + fq * 8), aq[ks], a);
        st[n] = a;
      }
      float mx = -1e30f;
#pragma unroll
      for (int n = 0; n < 4; ++n) {
        const uint32_t nib = ((n < 2 ? mthis[0] : mthis[1]) >> ((n & 1) * 16 + fq * 4)) & 15u;
#pragma unroll
        for (int j = 0; j < 4; ++j) {
          st[n][j] = (nib & (1u << j)) ? st[n][j] : -1e30f;
          mx = fmaxf(mx, st[n][j]);
        }
      }
      mx = fmaxf(mx, __shfl_xor(mx, 16));
      mx = fmaxf(mx, __shfl_xor(mx, 32));
      const float mnew = fmaxf(mrun, mx);
      const float alpha = __builtin_amdgcn_exp2f(mrun - mnew);
      mrun = mnew;
      float ps = 0.f;
#pragma unroll
      for (int n = 0; n < 4; ++n)
#pragma unroll
        for (int j = 0; j < 4; ++j) { st[n][j] = __builtin_amdgcn_exp2f(st[n][j] - mnew); ps += st[n][j]; }
      lrun = lrun * alpha + ps;
#pragma unroll
      for (int n = 0; n < 4; ++n)
#pragma unroll
        for (int j = 0; j < 4; ++j) Ot[n][j] *= alpha;
#pragma unroll
      for (int ks = 0; ks < 2; ++ks) {
        const bf16x8 pb = pack8_bf16(st[2 * ks][0], st[2 * ks][1], st[2 * ks][2], st[2 * ks][3],
                                     st[2 * ks + 1][0], st[2 * ks + 1][1], st[2 * ks + 1][2], st[2 * ks + 1][3]);
#pragma unroll
        for (int dt = 0; dt < 4; ++dt) {
          const u16* vr = sV + (dt * 16 + fr) * LR + ks * 32 + fq * 4;
          const u32x2 v0 = *reinterpret_cast<const u32x2*>(vr), v1 = *reinterpret_cast<const u32x2*>(vr + 16);
          const u32x4 vv = {v0[0], v0[1], v1[0], v1[1]};
          Ot[dt] = mfma16(__builtin_bit_cast(bf16x8, vv), pb, Ot[dt]);
        }
      }
    }
    __syncthreads();
  }
  if (active) {
    float ls = lrun;
    ls += __shfl_xor(ls, 16); ls += __shfl_xor(ls, 32);
    const float inv = 1.f / ls;
    const size_t ro = (size_t)(Rq0 + qrow + fr) * 512 + h * 64;
    u32x2 zz4[4];
#pragma unroll
    for (int dt = 0; dt < 4; ++dt) zz4[dt] = *reinterpret_cast<const u32x2*>(((u16*)(p.ws + WS_ZA)) + ro + dt * 16 + fq * 4);
#pragma unroll
    for (int dt = 0; dt < 4; ++dt) {
      const size_t o = ro + dt * 16 + fq * 4;
      const u32x2 zz = zz4[dt];
      const float z0 = __uint_as_float(zz[0] << 16), z1 = __uint_as_float(zz[0] & 0xffff0000u);
      const float z2 = __uint_as_float(zz[1] << 16), z3 = __uint_as_float(zz[1] & 0xffff0000u);
      u32x2 ov;
      ov[0] = pack2(Ot[dt][0] * inv * z0, Ot[dt][1] * inv * z1);
      ov[1] = pack2(Ot[dt][2] * inv * z2, Ot[dt][3] * inv * z3);
      *reinterpret_cast<u32x2*>(((u16*)(p.ws + WS_Q)) + o) = ov;
    }
  }
}

__device__ void phase_ssmB_attn(const Params& p, int l, char* lds) {
  const int x = blockIdx.x & 7, j = blockIdx.x >> 3, nb = gridDim.x >> 3;
  if (blockIdx.x >= gridDim.x - 64) {
    const int t = (gridDim.x - 1 - blockIdx.x) * 256 + tidx();
    const int pp = t & 63, g = (t >> 6) & 31, b = t >> 11;
    float ar = ((float*)(p.ws + WS_ab))[((size_t)(l * 32 + g) * 64 + pp) * 2], ai = ((float*)(p.ws + WS_ab))[((size_t)(l * 32 + g) * 64 + pp) * 2 + 1];
#pragma unroll
    for (int i = 0; i < 6; ++i) { const float nr = ar * ar - ai * ai, ni = 2.f * ar * ai; ar = nr; ai = ni; }
    float hr = 0.f, hi = 0.f;
    for (int c8 = 0; c8 < 128; c8 += 8) {
      float sr[8], si[8];
#pragma unroll
      for (int k = 0; k < 8; ++k) {
        const size_t o = ((size_t)(b * 128 + c8 + k) * 32 + g) * 64 + pp;
        sr[k] = ((float*)(p.ws + WS_SlocR))[o]; si[k] = ((float*)(p.ws + WS_SlocI))[o];
      }
#pragma unroll
      for (int k = 0; k < 8; ++k) {
        const size_t o = ((size_t)(b * 128 + c8 + k) * 32 + g) * 64 + pp;
        ((float*)(p.ws + WS_HstR))[o] = hr; ((float*)(p.ws + WS_HstI))[o] = hi;
        const float nhr = ar * hr - ai * hi + sr[k], nhi = ar * hi + ai * hr + si[k];
        hr = nhr; hi = nhi;
      }
    }
    p.out[O_SRP + (size_t)l * 16384 + (size_t)(b * 32 + g) * 64 + pp] = hr;
    p.out[O_SIP + (size_t)l * 16384 + (size_t)(b * 32 + g) * 64 + pp] = hi;
  }
  if (blockIdx.x < 128) attn_unit(p, true, blockIdx.x >> 3, 0, blockIdx.x & 7, lds);
  for (int pi = 0; pi < 8; ++pi) {
    const int pair = x + 8 * pi, b = pair >> 3, h = pair & 7;
    for (int c = j; c < 64; c += nb) {
      attn_unit(p, false, b, 127 - c, h, lds);
      attn_unit(p, false, b, c, h, lds);
    }
  }
}

__device__ void phase_ssmC(const Params& p, int l, char* lds) {
  const int wave = tidx() >> 6, lane = tidx() & 63;
  const int NU = (32768 + 512) / 4;
  for (int u = blockIdx.x; u < NU; u += gridDim.x) {
    const int wu = u * 4 + wave;
    u16* tile = reinterpret_cast<u16*>(lds) + wave * (64 * 136);
    if (wu < 32768) {
      const int g = wu & 31, c = (wu >> 5) & 127, b = wu >> 12;
      const size_t o = ((size_t)(b * 128 + c) * 32 + g) * 64 + lane;
      float hr = ((float*)(p.ws + WS_HstR))[o], hi = ((float*)(p.ws + WS_HstI))[o];
      ssm_unit(p, l, g, b * 8192 + c * 64, 64, hr, hi, true, tile);
    } else {
      const int i = wu - 32768;
      const int g = i & 31, b = i >> 5;
      const size_t si = ((size_t)(l * 16 + b) * 32 + g) * 64 + lane;
      float hr = p.st_re[si], hi = p.st_im[si];
      ssm_unit(p, l, g, NP + b * 32, 32, hr, hi, true, tile);
      p.out[O_SRS + si] = hr;
      p.out[O_SIS + si] = hi;
    }
  }
}

__device__ void phase_glu(const Params& p, int l, char* lds) {
  const int lane = tidx() & 63, wave = tidx() >> 6, wr = wave >> 1, wc = wave & 1, fr = lane & 15, fq = lane >> 4;
  GemmOrder ord; ord.init(NTOK / 128, 4);
  int mt, nt;
  while (ord.next(mt, nt)) {
    f32x4 acc[4][4];
    zero_acc<4>(acc);
    gemm_accum<4>(acc, ((u16*)(p.ws + WS_U)) + (size_t)mt * 128 * 512, 512, ((u16*)(p.ws + WS_WgluT)) + ((size_t)l * 512 + nt * 128) * 512, 512, 512, reinterpret_cast<u16*>(lds));
    float bg[4];
#pragma unroll
    for (int n = 0; n < 4; ++n) bg[n] = p.b_glu[l * 512 + nt * 128 + wc * 64 + n * 16 + fr];
#pragma unroll
    for (int m = 0; m < 4; ++m) {
      u16 yv[4][4], zv[4][4];
#pragma unroll
      for (int n = 0; n < 4; ++n)
#pragma unroll
        for (int j = 0; j < 4; ++j) {
          const size_t o = (size_t)(mt * 128 + wr * 64 + m * 16 + fq * 4 + j) * 512 + nt * 128 + wc * 64 + n * 16 + fr;
          yv[n][j] = ((u16*)(p.ws + WS_U))[o];
          zv[n][j] = ((u16*)(p.ws + WS_ZS))[o];
        }
#pragma unroll
      for (int n = 0; n < 4; ++n)
#pragma unroll
        for (int j = 0; j < 4; ++j) {
          const size_t o = (size_t)(mt * 128 + wr * 64 + m * 16 + fq * 4 + j) * 512 + nt * 128 + wc * 64 + n * 16 + fr;
          ((u16*)(p.ws + WS_ZS))[o] = f2bf(bf2f(yv[n][j]) * sigmoidf_(acc[m][n][j] + bg[n]) * bf2f(zv[n][j]));
        }
    }
  }
}
__device__ void phase_merge(const Params& p, int l, char* lds) {
  const int lane = tidx() & 63, wave = tidx() >> 6, wr = wave >> 1, wc = wave & 1, fr = lane & 15, fq = lane >> 4;
  u16* L = reinterpret_cast<u16*>(lds);
  GemmOrder ord; ord.init(NTOK / 128, 16);
  int mt, nt;
  while (ord.next(mt, nt)) {
    f32x4 acc[4][2], res[4][2];
    zero_acc<2>(acc);
    gemm_accum<2, true>(acc, ((u16*)(p.ws + WS_H)) + (size_t)mt * 128 * 1024, 1024, ((u16*)(p.ws + WS_WgT)) + ((size_t)l * 2048 + nt * 64) * 1024, 1024, 1024, L);
#pragma unroll
    for (int m = 0; m < 4; ++m)
#pragma unroll
      for (int n = 0; n < 2; ++n)
#pragma unroll
        for (int j = 0; j < 4; ++j) res[m][n][j] = sigmoidf_(acc[m][n][j]);
    zero_acc<2>(acc);
    gemm_accum<2>(acc, ((u16*)(p.ws + WS_ZS)) + (size_t)mt * 128 * 512, 512, ((u16*)(p.ws + WS_WpsT)) + ((size_t)l * 1024 + nt * 64) * 512, 512, 512, L);
#pragma unroll
    for (int m = 0; m < 4; ++m)
#pragma unroll
      for (int n = 0; n < 2; ++n)
#pragma unroll
        for (int j = 0; j < 4; ++j) res[m][n][j] *= acc[m][n][j];
    f32x4 gt[4][2];
    zero_acc<2>(gt);
    gemm_accum<2, true>(gt, ((u16*)(p.ws + WS_H)) + (size_t)mt * 128 * 1024, 1024, ((u16*)(p.ws + WS_WgT)) + ((size_t)l * 2048 + 1024 + nt * 64) * 1024, 1024, 1024, L);
    zero_acc<2>(acc);
    gemm_accum<2>(acc, ((u16*)(p.ws + WS_Q)) + (size_t)mt * 128 * 512, 512, ((u16*)(p.ws + WS_WpaT)) + ((size_t)l * 1024 + nt * 64) * 512, 512, 512, L);
#pragma unroll
    for (int m = 0; m < 4; ++m)
#pragma unroll
      for (int n = 0; n < 2; ++n) {
        const int C = nt * 64 + wc * 32 + n * 16 + fr;
#pragma unroll
        for (int j = 0; j < 4; ++j) {
          const float v = res[m][n][j] + sigmoidf_(gt[m][n][j]) * acc[m][n][j];
          ((u16*)(p.ws + WS_U))[(size_t)(mt * 128 + wr * 64 + m * 16 + fq * 4 + j) * 1024 + C] = f2bf(v);
        }
      }
  }
}

__device__ void phase_out(const Params& p, int l, char* lds) {
  const int lane = tidx() & 63, wave = tidx() >> 6, wr = wave >> 1, wc = wave & 1, fr = lane & 15, fq = lane >> 4;
  GemmOrder ord; ord.init(NTOK / 128, 8);
  int mt, nt;
  while (ord.next(mt, nt)) {
    f32x4 acc[4][4];
    zero_acc<4>(acc);
    gemm_accum<4>(acc, ((u16*)(p.ws + WS_U)) + (size_t)mt * 128 * 1024, 1024, ((u16*)(p.ws + WS_WoT)) + ((size_t)l * 1024 + nt * 128) * 1024, 1024, 1024, reinterpret_cast<u16*>(lds));
    float xo[4][4][4];
#pragma unroll
    for (int m = 0; m < 4; ++m) {
      const int R0 = mt * 128 + wr * 64 + m * 16 + fq * 4;
#pragma unroll
      for (int j = 0; j < 4; ++j) {
        const float* xr = xin_row(p, l, R0 + j) + nt * 128 + wc * 64 + fr;
#pragma unroll
        for (int n = 0; n < 4; ++n) xo[m][n][j] = xr[n * 16];
      }
    }
#pragma unroll
    for (int m = 0; m < 4; ++m) {
      const int R0 = mt * 128 + wr * 64 + m * 16 + fq * 4;
      const float* gate = ((float*)(p.ws + WS_mod)) + ((size_t)l * 24 + batch_of(R0)) * 3072 + 2048;
#pragma unroll
      for (int n = 0; n < 4; ++n) {
        const int C = nt * 128 + wc * 64 + n * 16 + fr;
        const float gv = gate[C];
#pragma unroll
        for (int j = 0; j < 4; ++j) p.out[(size_t)(R0 + j) * 1024 + C] = xo[m][n][j] + gv * acc[m][n][j];
      }
    }
  }
}

__device__ void phase_final(const Params& p) {
  const int wave = tidx() >> 6, lane = tidx() & 63;
  const int gw = blockIdx.x * 4 + wave, nw = gridDim.x * 4;
  for (int R = gw; R < NTOK; R += nw) {
    float* x = p.out + (size_t)R * 1024;
    float4 v[4];
    float ss = 0.f;
#pragma unroll
    for (int i = 0; i < 4; ++i) {
      v[i] = *reinterpret_cast<const float4*>(x + i * 256 + lane * 4);
      ss += v[i].x * v[i].x + v[i].y * v[i].y + v[i].z * v[i].z + v[i].w * v[i].w;
    }
    ss = wave_sum(ss);
    const float rstd = rsqrtf(ss * (1.f / 1024.f) + 1e-6f);
#pragma unroll
    for (int i = 0; i < 4; ++i) {
      const int c = i * 256 + lane * 4;
      const float4 g4 = *reinterpret_cast<const float4*>(p.g_final + c);
      float4 o;
      o.x = v[i].x * rstd * g4.x; o.y = v[i].y * rstd * g4.y; o.z = v[i].z * rstd * g4.z; o.w = v[i].w * rstd * g4.w;
      *reinterpret_cast<float4*>(x + c) = o;
    }
  }
}

__global__ void __launch_bounds__(256, 2) fwd_megakernel(Params p) {
  extern __shared__ __attribute__((aligned(16))) char lds[];
  cg::grid_group grid = cg::this_grid();
  for (int ph = p.phase_lo; ph <= p.phase_hi; ++ph) {
    if (ph > p.phase_lo) grid.sync();
    Params q = p;
#define LAUNDER(f) asm volatile("" : "+s"(q.f))
    LAUNDER(x_prompt); LAUNDER(x_sample); LAUNDER(cache_k); LAUNDER(cache_v); LAUNDER(cache_kidx); LAUNDER(st_re); LAUNDER(st_im);
    LAUNDER(c_prompt); LAUNDER(c_sample); LAUNDER(w_mod); LAUNDER(b_mod); LAUNDER(g_norm); LAUNDER(w_in); LAUNDER(a_re); LAUNDER(a_im);
    LAUNDER(log_dt); LAUNDER(b_re); LAUNDER(b_im); LAUNDER(c_re); LAUNDER(c_im); LAUNDER(d_skip); LAUNDER(w_glu); LAUNDER(b_glu);
    LAUNDER(w_ps); LAUNDER(w_pa); LAUNDER(w_o); LAUNDER(g_final); LAUNDER(out); LAUNDER(ws);
#undef LAUNDER
    if (ph == 0) phase_prep(q, lds);
    else if (ph == NPHASE - 1) phase_final(q);
    else {
      const int l = (ph - 1) >> 3, s = (ph - 1) & 7;
      switch (s) {
        case 0: phase_norm(q, l); break;
        case 1: phase_inproj(q, l, lds); break;
        case 2: phase_ssmA_indexer(q, l, lds); break;
        case 3: phase_ssmB_attn(q, l, lds); break;
        case 4: phase_ssmC(q, l, lds); break;
        case 5: phase_glu(q, l, lds); break;
        case 6: phase_merge(q, l, lds); break;
        default: phase_out(q, l, lds); break;
      }
    }
  }
}

extern "C" void kernel_launch(void* const* d_in, const int* in_sizes, int n_in, void* d_out, int out_size, void* d_ws, size_t ws_size,
                              hipStream_t stream) {
  static int grid_blocks = 0;
  if (!grid_blocks) {
    int dev = 0, cus = 0, per_cu = 0;
    hipGetDevice(&dev);
    hipDeviceGetAttribute(&cus, hipDeviceAttributeMultiprocessorCount, dev);
    hipFuncSetAttribute((const void*)fwd_megakernel, hipFuncAttributeMaxDynamicSharedMemorySize, LDS_BYTES);
    hipOccupancyMaxActiveBlocksPerMultiprocessor(&per_cu, (const void*)fwd_megakernel, 256, LDS_BYTES);
    if (per_cu < 1) per_cu = 1;
    if (per_cu > 2) per_cu = 2;
    grid_blocks = cus * per_cu;
  }
  Params p{};
  const float* const* in = reinterpret_cast<const float* const*>(d_in);
  p.x_prompt = in[0]; p.x_sample = in[1]; p.cache_k = in[2]; p.cache_v = in[3]; p.cache_kidx = in[4];
  p.st_re = in[5]; p.st_im = in[6]; p.c_prompt = in[7]; p.c_sample = in[8];
  p.w_mod = in[9]; p.b_mod = in[10]; p.g_norm = in[11]; p.w_in = in[12]; p.a_re = in[13]; p.a_im = in[14]; p.log_dt = in[15];
  p.b_re = in[16]; p.b_im = in[17]; p.c_re = in[18]; p.c_im = in[19]; p.d_skip = in[20];
  p.w_glu = in[21]; p.b_glu = in[22]; p.w_ps = in[23]; p.w_pa = in[24]; p.w_o = in[25]; p.g_final = in[26];
  p.out = (float*)d_out;
  p.ws = (char*)d_ws;
  if (WS_TOTAL > ws_size) fprintf(stderr, "kernel_launch: workspace too small: need %zu have %zu\n", (size_t)WS_TOTAL, ws_size);
#if MULTI_LAUNCH
  for (int ph = 0; ph < NPHASE; ++ph) {
    p.phase_lo = ph; p.phase_hi = ph;
    hipLaunchKernelGGL(fwd_megakernel, dim3(grid_blocks), dim3(256), LDS_BYTES, stream, p);
  }
#else
  p.phase_lo = 0; p.phase_hi = NPHASE - 1;
  void* args[] = {&p};
  hipError_t e = hipLaunchCooperativeKernel((void*)fwd_megakernel, dim3(grid_blocks), dim3(256), args, LDS_BYTES, stream);
  if (e != hipSuccess) fprintf(stderr, "cooperative launch failed: %s (grid %d)\n", hipGetErrorString(e), grid_blocks);
#endif
}
```

```cpp
#include <hip/hip_runtime.h>
#include <hip/hip_cooperative_groups.h>
#include <stdint.h>
#include <stdio.h>
namespace cg = cooperative_groups;

#ifndef MULTI_LAUNCH
#define MULTI_LAUNCH 0
#endif

#define DI __device__ __forceinline__
typedef __attribute__((ext_vector_type(8))) short bf16x8;
typedef __attribute__((ext_vector_type(4))) float f32x4;
typedef unsigned short u16;
typedef __attribute__((ext_vector_type(4))) unsigned u32x4;
typedef __attribute__((ext_vector_type(2))) unsigned u32x2;

constexpr int NP = 65536, NS = 512, NTOK = NP + NS;
constexpr int D_IN = 5704, N_IN1 = 3656, N_IN1P = 3712;
constexpr int KS_ROWS = 4160, KIS_ROWS = 4128, MS_ROW = 264;
constexpr int LDS_BYTES = 73728;
constexpr int NPHASE = 18;

constexpr size_t O_KP = 67633152, O_VP = 134742016, O_KIP = 201850880, O_SRP = 210239488, O_SIP = 210272256,
                 O_KS = 210305024, O_VS = 210829312, O_KIS = 211353600, O_SRS = 211419136, O_SIS = 211484672;

struct Params {
  const float *x_prompt, *x_sample, *cache_k, *cache_v, *cache_kidx, *st_re, *st_im, *c_prompt, *c_sample;
  const float *w_mod, *b_mod, *g_norm, *w_in, *a_re, *a_im, *log_dt, *b_re, *b_im, *c_re, *c_im, *d_skip;
  const float *w_glu, *b_glu, *w_ps, *w_pa, *w_o, *g_final;
  float* out;
  char* ws;
  int phase_lo, phase_hi;
};
constexpr size_t al256(size_t x) { return (x + 255) & ~(size_t)255; }
constexpr size_t WS_WinT = 0;
constexpr size_t WS_WgT = WS_WinT + al256((size_t)2 * N_IN1P * 1024 * 2);
constexpr size_t WS_WgluT = WS_WgT + al256((size_t)2 * 2048 * 1024 * 2);
constexpr size_t WS_WpsT = WS_WgluT + al256((size_t)2 * 512 * 512 * 2);
constexpr size_t WS_WpaT = WS_WpsT + al256((size_t)2 * 1024 * 512 * 2);
constexpr size_t WS_WoT = WS_WpaT + al256((size_t)2 * 1024 * 512 * 2);
constexpr size_t WS_mod = WS_WoT + al256((size_t)2 * 1024 * 1024 * 2);
constexpr size_t WS_ab = WS_mod + al256((size_t)2 * 24 * 3072 * 4);
constexpr size_t WS_Bmat = WS_ab + al256((size_t)2 * 32 * 64 * 2 * 4);
constexpr size_t WS_Cmat = WS_Bmat + al256((size_t)2 * 32 * 128 * 16 * 2);
constexpr size_t WS_H = WS_Cmat + al256((size_t)2 * 32 * 16 * 128 * 2);
constexpr size_t WS_U = WS_H + al256((size_t)NTOK * 1024 * 2);
constexpr size_t WS_QI = WS_U + (size_t)NTOK * 512 * 2;
constexpr size_t WS_ZS = WS_QI + al256((size_t)NTOK * 512 * 2);
constexpr size_t WS_Q = WS_ZS + al256((size_t)NTOK * 512 * 2);
constexpr size_t WS_ZA = WS_Q + al256((size_t)NTOK * 512 * 2);
constexpr size_t WS_Kp = WS_ZA + al256((size_t)NTOK * 512 * 2);
constexpr size_t WS_VTp = WS_Kp + al256((size_t)NP * 512 * 2);
constexpr size_t WS_KIp = WS_VTp + al256((size_t)NP * 512 * 2);
constexpr size_t WS_Ks = WS_KIp + al256((size_t)NP * 64 * 2);
constexpr size_t WS_VTs = WS_Ks + al256((size_t)16 * KS_ROWS * 512 * 2);
constexpr size_t WS_KIs = WS_VTs + al256((size_t)16 * 512 * KS_ROWS * 2);
constexpr size_t WS_WI = WS_KIs + al256((size_t)16 * KIS_ROWS * 64 * 2);
constexpr size_t WS_SlocR = WS_WI + al256((size_t)NTOK * 8 * 4);
constexpr size_t WS_SlocI = WS_SlocR + al256((size_t)8 * 128 * 32 * 64 * 4);
constexpr size_t WS_HstR = WS_SlocI + al256((size_t)8 * 128 * 32 * 64 * 4);
constexpr size_t WS_HstI = WS_HstR + al256((size_t)8 * 128 * 32 * 64 * 4);
constexpr size_t WS_maskp = WS_HstI + al256((size_t)8 * 128 * 32 * 64 * 4);
constexpr size_t WS_masks = WS_maskp + al256((size_t)NP * 512 * 2);
constexpr size_t WS_BbF = WS_masks + al256((size_t)NS * MS_ROW * 2);
constexpr size_t WS_TOTAL = WS_BbF + al256((size_t)64 * 2 * 16 * 64 * 4);

DI u16 f2bf(float x) { uint32_t u = __float_as_uint(x); u += 0x7fffu + ((u >> 16) & 1u); return (u16)(u >> 16); }
DI float bf2f(u16 h) { return __uint_as_float(((uint32_t)h) << 16); }
DI uint32_t pack2(float a, float b) { return (uint32_t)f2bf(a) | ((uint32_t)f2bf(b) << 16); }
DI float sigmoidf_(float x) { return 1.f / (1.f + __expf(-x)); }
DI float siluf_(float x) { return x * sigmoidf_(x); }
DI float geluf_(float v) { return v * sigmoidf_(1.5957691216f * (v + 0.044715f * v * v * v)); }
DI float wave_sum(float v) {
#pragma unroll
  for (int o = 32; o > 0; o >>= 1) v += __shfl_xor(v, o);
  return v;
}
DI int tidx() { int t = threadIdx.x; asm volatile("" : "+v"(t)); return t; }
DI void wave_lds_sync() { asm volatile("s_waitcnt lgkmcnt(0)" ::: "memory"); }
DI f32x4 mfma16(bf16x8 a, bf16x8 b, f32x4 c) { return __builtin_amdgcn_mfma_f32_16x16x32_bf16(a, b, c, 0, 0, 0); }
typedef _Float16 f16x8 __attribute__((ext_vector_type(8)));
DI f32x4 mfma16h(bf16x8 a, bf16x8 b, f32x4 c) { return __builtin_amdgcn_mfma_f32_16x16x32_f16(__builtin_bit_cast(f16x8, a), __builtin_bit_cast(f16x8, b), c, 0, 0, 0); }
DI u16 f2h(float x) { const _Float16 h = (_Float16)x; return __builtin_bit_cast(u16, h); }
DI uint32_t pack2h(float a, float b) { return (uint32_t)f2h(a) | ((uint32_t)f2h(b) << 16); }
DI bf16x8 ldg8(const u16* p) { return *reinterpret_cast<const bf16x8*>(p); }
DI bf16x8 zero8() { bf16x8 z = {0, 0, 0, 0, 0, 0, 0, 0}; return z; }

DI const float* xin_row(const Params& p, int l, int R) {
  if (l == 0) return R < NP ? p.x_prompt + (size_t)R * 1024 : p.x_sample + (size_t)(R - NP) * 1024;
  return p.out + (size_t)R * 1024;
}
DI int batch_of(int R) { return R < NP ? (R >> 13) : 8 + ((R - NP) >> 5); }

template <int NT, bool F16 = false>
DI void gemm_accum(f32x4 (&acc)[4][NT], const u16* __restrict__ A, int lda, const u16* __restrict__ Bt, int ldb, int K, u16* lds) {
  constexpr int LR = 72;
  constexpr int BN = 32 * NT;
  constexpr int NBCH = BN / 32;
  constexpr int BUF = 256 * LR;
  const int tid = tidx(), lane = tid & 63, wave = tid >> 6, wr = wave >> 1, wc = wave & 1, fr = lane & 15, fq = lane >> 4;
  u32x4 ra[4], rb[NBCH];
  const int crow = tid >> 3, cch = tid & 7;
  const u16* Ap = A + (size_t)crow * lda + cch * 8;
  const u16* Bp = Bt + (size_t)crow * ldb + cch * 8;
  const int nk = K >> 6;
  auto gload = [&](int kt) {
    const int k0 = kt << 6;
#pragma unroll
    for (int i = 0; i < 4; ++i) ra[i] = *reinterpret_cast<const u32x4*>(Ap + (size_t)(i * 32) * lda + k0);
#pragma unroll
    for (int i = 0; i < NBCH; ++i) rb[i] = *reinterpret_cast<const u32x4*>(Bp + (size_t)(i * 32) * ldb + k0);
  };
  auto lstore = [&](int buf) {
    u16* sA = lds + buf * BUF;
    u16* sB = sA + 128 * LR;
#pragma unroll
    for (int i = 0; i < 4; ++i) *reinterpret_cast<u32x4*>(sA + (crow + i * 32) * LR + cch * 8) = ra[i];
#pragma unroll
    for (int i = 0; i < NBCH; ++i) *reinterpret_cast<u32x4*>(sB + (crow + i * 32) * LR + cch * 8) = rb[i];
  };
  gload(0);
  __syncthreads();
  lstore(0);
  if (nk > 1) gload(1);
  __syncthreads();
  for (int kt = 0; kt < nk; ++kt) {
    const int cur = kt & 1;
    if (kt + 1 < nk) lstore(cur ^ 1);
    if (kt + 2 < nk) gload(kt + 2);
    const u16* sA = lds + cur * BUF;
    const u16* sB = sA + 128 * LR;
#pragma unroll
    for (int ks = 0; ks < 2; ++ks) {
      bf16x8 a[4], b[NT];
#pragma unroll
      for (int m = 0; m < 4; ++m) a[m] = *reinterpret_cast<const bf16x8*>(sA + (wr * 64 + m * 16 + fr) * LR + ks * 32 + fq * 8);
#pragma unroll
      for (int n = 0; n < NT; ++n) b[n] = *reinterpret_cast<const bf16x8*>(sB + (wc * 16 * NT + n * 16 + fr) * LR + ks * 32 + fq * 8);
#pragma unroll
      for (int m = 0; m < 4; ++m)
#pragma unroll
        for (int n = 0; n < NT; ++n) acc[m][n] = F16 ? mfma16h(a[m], b[n], acc[m][n]) : mfma16(a[m], b[n], acc[m][n]);
    }
    __syncthreads();
  }
}
template <int NT>
DI void zero_acc(f32x4 (&acc)[4][NT]) {
#pragma unroll
  for (int m = 0; m < 4; ++m)
#pragma unroll
    for (int n = 0; n < NT; ++n) acc[m][n] = f32x4{0.f, 0.f, 0.f, 0.f};
}


struct GemmOrder {
  int x, j, nb, cnt, NN, k;
  DI void init(int nM, int NN_) { x = blockIdx.x & 7; j = blockIdx.x >> 3; nb = gridDim.x >> 3; cnt = (nM - x + 7) >> 3; NN = NN_; k = 0; }
  DI bool next(int& mt, int& nt) {
    for (;;) {
      const int s = j + nb * k; ++k;
      const int g = s / (4 * NN), r = s - g * (4 * NN);
      if (g * 4 >= cnt) return false;
      const int i = g * 4 + (r & 3);
      if (i >= cnt) continue;
      mt = x + 8 * i; nt = r >> 2; return true;
    }
  }
};
template <bool F16, bool PERM = false>
DI void transpose_w(const float* __restrict__ W, int K, int N, int n0, int ncount, u16* __restrict__ WT, int gtid, int gstride) {
  const int total = ncount * (K >> 3);
  for (int idx = gtid; idx < total; idx += gstride) {
    const int n = idx % ncount, kb = idx / ncount;
    int nsrc = n;
    if (PERM) { const int ntile = n >> 7, r = n & 127, wc = r >> 6, sub = (r >> 4) & 3, f = r & 15; nsrc = (sub >= 2 ? 1024 : 0) + ntile * 64 + wc * 32 + (sub & 1) * 16 + f; }
    const float* src = W + (size_t)(kb * 8) * N + n0 + nsrc;
    float f[8];
#pragma unroll
    for (int j = 0; j < 8; ++j) f[j] = src[(size_t)j * N];
    uint4 o;
    if (F16) { o.x = pack2h(f[0], f[1]); o.y = pack2h(f[2], f[3]); o.z = pack2h(f[4], f[5]); o.w = pack2h(f[6], f[7]); }
    else { o.x = pack2(f[0], f[1]); o.y = pack2(f[2], f[3]); o.z = pack2(f[4], f[5]); o.w = pack2(f[6], f[7]); }
    *reinterpret_cast<uint4*>(WT + (size_t)n * K + kb * 8) = o;
  }
}

__device__ void phase_prep(const Params& p, char* lds) {
  const int gtid = blockIdx.x * 256 + tidx(), gstride = gridDim.x * 256;
  for (int l = 0; l < 2; ++l) {
    transpose_w<true>(p.w_in + (size_t)l * 1024 * D_IN, 1024, D_IN, 0, N_IN1, ((u16*)(p.ws + WS_WinT)) + (size_t)l * N_IN1P * 1024, gtid, gstride);
    transpose_w<true, true>(p.w_in + (size_t)l * 1024 * D_IN, 1024, D_IN, N_IN1, 2048, ((u16*)(p.ws + WS_WgT)) + (size_t)l * 2048 * 1024, gtid, gstride);
    transpose_w<false>(p.w_glu + (size_t)l * 512 * 512, 512, 512, 0, 512, ((u16*)(p.ws + WS_WgluT)) + (size_t)l * 512 * 512, gtid, gstride);
    transpose_w<false>(p.w_ps + (size_t)l * 512 * 1024, 512, 1024, 0, 1024, ((u16*)(p.ws + WS_WpsT)) + (size_t)l * 1024 * 512, gtid, gstride);
    transpose_w<false>(p.w_pa + (size_t)l * 512 * 1024, 512, 1024, 0, 1024, ((u16*)(p.ws + WS_WpaT)) + (size_t)l * 1024 * 512, gtid, gstride);
    transpose_w<false>(p.w_o + (size_t)l * 1024 * 1024, 1024, 1024, 0, 1024, ((u16*)(p.ws + WS_WoT)) + (size_t)l * 1024 * 1024, gtid, gstride);
  }
  for (int idx = gtid; idx < 2 * 32 * 64; idx += gstride) {
    const int lg = idx >> 6, pp = idx & 63;
    const float are = p.a_re[idx], aim = p.a_im[idx];
    const float dt = expf(p.log_dt[lg]);
    const float mag = expf(are * dt), ang = aim * dt;
    const float kk = rintf(ang * 0.15915494309189535f);
    float r = fmaf(-kk, 6.2831854820251465f, ang);
    r = fmaf(-kk, -1.7484556e-07f, r);
    const float cs = cosf(r), sn = sinf(r);
    const float abr = mag * cs, abi = mag * sn;
    const float den = are * are + aim * aim;
    const float nr = abr - 1.f, ni = abi;
    const float fre = (nr * are + ni * aim) / den, fim = (ni * are - nr * aim) / den;
    ((float*)(p.ws + WS_ab))[idx * 2] = abr; ((float*)(p.ws + WS_ab))[idx * 2 + 1] = abi;
#pragma unroll
    for (int n = 0; n < 16; ++n) {
      const float br = p.b_re[(size_t)idx * 16 + n], bi = p.b_im[(size_t)idx * 16 + n];
      ((float*)(p.ws + WS_BbF))[(((size_t)lg * 2 + 0) * 16 + n) * 64 + pp] = fre * br - fim * bi;
      ((float*)(p.ws + WS_BbF))[(((size_t)lg * 2 + 1) * 16 + n) * 64 + pp] = fre * bi + fim * br;
      ((u16*)(p.ws + WS_Bmat))[((size_t)lg * 128 + pp) * 16 + n] = f2bf(fre * br - fim * bi);
      ((u16*)(p.ws + WS_Bmat))[((size_t)lg * 128 + 64 + pp) * 16 + n] = f2bf(fre * bi + fim * br);
      ((u16*)(p.ws + WS_Cmat))[((size_t)lg * 16 + n) * 128 + pp] = f2bf(p.c_re[((size_t)lg * 16 + n) * 64 + pp]);
      ((u16*)(p.ws + WS_Cmat))[((size_t)lg * 16 + n) * 128 + 64 + pp] = f2bf(-p.c_im[((size_t)lg * 16 + n) * 64 + pp]);
    }
  }
  float* red = reinterpret_cast<float*>(lds);
  for (int u = blockIdx.x; u < 192; u += gridDim.x) {
    const int l = u / 96, cg_ = u % 96;
    const int col = tidx() & 31, ks = tidx() >> 5;
    float acc[24];
#pragma unroll
    for (int r = 0; r < 24; ++r) acc[r] = 0.f;
    const float* wm = p.w_mod + (size_t)l * 1024 * 3072 + cg_ * 32 + col;
    for (int k = ks * 128; k < ks * 128 + 128; ++k) {
      const float w = wm[(size_t)k * 3072];
#pragma unroll
      for (int r = 0; r < 24; ++r) {
        const float c = r < 8 ? p.c_prompt[r * 1024 + k] : p.c_sample[(r - 8) * 1024 + k];
        acc[r] = fmaf(siluf_(c), w, acc[r]);
      }
    }
    __syncthreads();
#pragma unroll
    for (int r = 0; r < 24; ++r) red[(ks * 24 + r) * 32 + col] = acc[r];
    __syncthreads();
    for (int o = tidx(); o < 768; o += 256) {
      const int r = o >> 5, c = o & 31;
      float s = p.b_mod[l * 3072 + cg_ * 32 + c];
#pragma unroll
      for (int k8 = 0; k8 < 8; ++k8) s += red[(k8 * 24 + r) * 32 + c];
      ((float*)(p.ws + WS_mod))[((size_t)l * 24 + r) * 3072 + cg_ * 32 + c] = s;
    }
  }
}

__device__ void phase_norm(const Params& p, int l) {
  const int wave = tidx() >> 6, lane = tidx() & 63;
  const int gw = blockIdx.x * 4 + wave, nw = gridDim.x * 4;
  const float* gn = p.g_norm + l * 1024;
  for (int R = gw; R < NTOK; R += nw) {
    const float* x = xin_row(p, l, R);
    float4 v[4];
    float ss = 0.f;
#pragma unroll
    for (int i = 0; i < 4; ++i) {
      v[i] = *reinterpret_cast<const float4*>(x + i * 256 + lane * 4);
      ss += v[i].x * v[i].x + v[i].y * v[i].y + v[i].z * v[i].z + v[i].w * v[i].w;
    }
    ss = wave_sum(ss);
    const float rstd = rsqrtf(ss * (1.f / 1024.f) + 1e-6f);
    const float* md = ((float*)(p.ws + WS_mod)) + ((size_t)l * 24 + batch_of(R)) * 3072;
#pragma unroll
    for (int i = 0; i < 4; ++i) {
      const int c = i * 256 + lane * 4;
      const float4 g4 = *reinterpret_cast<const float4*>(gn + c);
      const float4 sh = *reinterpret_cast<const float4*>(md + c);
      const float4 sc = *reinterpret_cast<const float4*>(md + 1024 + c);
      uint2 o;
      o.x = pack2h(v[i].x * rstd * g4.x * (1.f + sc.x) + sh.x, v[i].y * rstd * g4.y * (1.f + sc.y) + sh.y);
      o.y = pack2h(v[i].z * rstd * g4.z * (1.f + sc.z) + sh.z, v[i].w * rstd * g4.w * (1.f + sc.w) + sh.w);
      *reinterpret_cast<uint2*>(((u16*)(p.ws + WS_H)) + (size_t)R * 1024 + c) = o;
    }
  }
  const int gtid = blockIdx.x * 256 + tidx(), gstride = gridDim.x * 256;
  {
    const float* ck = p.cache_k + (size_t)l * 16 * 4096 * 512;
    for (int idx = gtid; idx < 16 * 4096 * 512 / 8; idx += gstride) {
      const size_t e = (size_t)idx * 8;
      const int b = (int)(e / (4096 * 512)), rem = (int)(e % (4096 * 512));
      const float4 a = *reinterpret_cast<const float4*>(ck + e), c = *reinterpret_cast<const float4*>(ck + e + 4);
      uint4 o; o.x = pack2(a.x, a.y); o.y = pack2(a.z, a.w); o.z = pack2(c.x, c.y); o.w = pack2(c.z, c.w);
      *reinterpret_cast<uint4*>(((u16*)(p.ws + WS_Ks)) + (size_t)b * KS_ROWS * 512 + rem) = o;
    }
    const float* cki = p.cache_kidx + (size_t)l * 16 * 4096 * 64;
    for (int idx = gtid; idx < 16 * 4096 * 64 / 8; idx += gstride) {
      const size_t e = (size_t)idx * 8;
      const int b = (int)(e / (4096 * 64)), rem = (int)(e % (4096 * 64));
      const float4 a = *reinterpret_cast<const float4*>(cki + e), c = *reinterpret_cast<const float4*>(cki + e + 4);
      uint4 o; o.x = pack2h(a.x, a.y); o.y = pack2h(a.z, a.w); o.z = pack2h(c.x, c.y); o.w = pack2h(c.z, c.w);
      *reinterpret_cast<uint4*>(((u16*)(p.ws + WS_KIs)) + (size_t)b * KIS_ROWS * 64 + rem) = o;
    }
    const float* cv = p.cache_v + (size_t)l * 16 * 4096 * 512;
    for (int idx = gtid; idx < 16 * 512 * 512; idx += gstride) {
      const int c = idx & 511, sb = (idx >> 9) & 511, b = idx >> 18;
      const float* src = cv + ((size_t)b * 4096 + sb * 8) * 512 + c;
      float f[8];
#pragma unroll
      for (int j = 0; j < 8; ++j) f[j] = src[(size_t)j * 512];
      uint4 o; o.x = pack2(f[0], f[1]); o.y = pack2(f[2], f[3]); o.z = pack2(f[4], f[5]); o.w = pack2(f[6], f[7]);
      *reinterpret_cast<uint4*>(((u16*)(p.ws + WS_VTs)) + ((size_t)b * 512 + c) * KS_ROWS + sb * 8) = o;
    }
  }
}

__device__ void phase_inproj(const Params& p, int l, char* lds) {
  const int lane = tidx() & 63, wave = tidx() >> 6, wr = wave >> 1, wc = wave & 1, fr = lane & 15, fq = lane >> 4;
  GemmOrder ord; ord.init(NTOK / 128, 29);
  int mt, nt;
  while (ord.next(mt, nt)) {
    f32x4 acc[4][4];
    zero_acc<4>(acc);
    gemm_accum<4, true>(acc, ((u16*)(p.ws + WS_H)) + (size_t)mt * 128 * 1024, 1024, ((u16*)(p.ws + WS_WinT)) + ((size_t)l * N_IN1P + nt * 128) * 1024, 1024, 1024, reinterpret_cast<u16*>(lds));
    const int region = nt >> 2;
#pragma unroll
    for (int m = 0; m < 4; ++m) {
      const int R0 = mt * 128 + wr * 64 + m * 16 + fq * 4;
      const bool smp = R0 >= NP;
      const int rs = R0 - NP;
      const int b = smp ? (rs >> 5) : (R0 >> 13);
      const int s0 = smp ? (rs & 31) : (R0 & 8191);
#pragma unroll
      for (int n = 0; n < 4; ++n) {
        const int C = nt * 128 + wc * 64 + n * 16 + fr;
        const f32x4 v = acc[m][n];
        if (region == 0) {
#pragma unroll
          for (int j = 0; j < 4; ++j) ((u16*)(p.ws + WS_U))[(size_t)(R0 + j) * 512 + C] = f2bf(v[j]);
        } else if (region == 1) {
#pragma unroll
          for (int j = 0; j < 4; ++j) ((u16*)(p.ws + WS_ZS))[(size_t)(R0 + j) * 512 + (C - 512)] = f2bf(siluf_(v[j]));
        } else if (region == 2) {
#pragma unroll
          for (int j = 0; j < 4; ++j) ((u16*)(p.ws + WS_Q))[(size_t)(R0 + j) * 512 + (C - 1024)] = f2bf(v[j] * 0.18033688011112042f);
        } else if (region == 3) {
          const int cc = C - 1536;
          float* of = smp ? p.out + O_KS + (size_t)l * 262144 + (size_t)rs * 512 + cc : p.out + O_KP + (size_t)l * 33554432 + (size_t)R0 * 512 + cc;
          u16* ob = smp ? ((u16*)(p.ws + WS_Ks)) + ((size_t)b * KS_ROWS + 4096 + s0) * 512 + cc : ((u16*)(p.ws + WS_Kp)) + (size_t)R0 * 512 + cc;
#pragma unroll
          for (int j = 0; j < 4; ++j) { of[(size_t)j * 512] = v[j]; ob[(size_t)j * 512] = f2bf(v[j]); }
        } else if (region == 4) {
          const int cc = C - 2048;
          float* of = smp ? p.out + O_VS + (size_t)l * 262144 + (size_t)rs * 512 + cc : p.out + O_VP + (size_t)l * 33554432 + (size_t)R0 * 512 + cc;
#pragma unroll
          for (int j = 0; j < 4; ++j) of[(size_t)j * 512] = v[j];
          uint2 o; o.x = pack2(v[0], v[1]); o.y = pack2(v[2], v[3]);
          u16* ob = smp ? ((u16*)(p.ws + WS_VTs)) + ((size_t)b * 512 + cc) * KS_ROWS + 4096 + s0 : ((u16*)(p.ws + WS_VTp)) + ((size_t)b * 512 + cc) * 8192 + s0;
          *reinterpret_cast<uint2*>(ob) = o;
        } else if (region == 5) {
#pragma unroll
          for (int j = 0; j < 4; ++j) ((u16*)(p.ws + WS_ZA))[(size_t)(R0 + j) * 512 + (C - 2560)] = f2bf(siluf_(v[j]));
        } else if (region == 6) {
#pragma unroll
          for (int j = 0; j < 4; ++j) ((u16*)(p.ws + WS_QI))[(size_t)(R0 + j) * 512 + (C - 3072)] = f2h(v[j] * 0.125f);
        } else {
          if (C < 3648) {
            const int cc = C - 3584;
            float* of = smp ? p.out + O_KIS + (size_t)l * 32768 + (size_t)rs * 64 + cc : p.out + O_KIP + (size_t)l * 4194304 + (size_t)R0 * 64 + cc;
            u16* ob = smp ? ((u16*)(p.ws + WS_KIs)) + ((size_t)b * KIS_ROWS + 4096 + s0) * 64 + cc : ((u16*)(p.ws + WS_KIp)) + (size_t)R0 * 64 + cc;
#pragma unroll
            for (int j = 0; j < 4; ++j) { of[(size_t)j * 64] = v[j]; ob[(size_t)j * 64] = f2h(v[j]); }
          } else if (C < 3656) {
#pragma unroll
            for (int j = 0; j < 4; ++j) ((float*)(p.ws + WS_WI))[(size_t)(R0 + j) * 8 + (C - 3648)] = v[j] * 0.35355339059327373f;
          }
        }
      }
    }
  }
}

DI void ssm_unit(const Params& p, int l, int g, int row0, int T, float& hr, float& hi, bool write_y, u16* tile) {
  const int lane = tidx() & 63, fr = lane & 15, fq = lane >> 4;
  const int lg = l * 32 + g;
  const float abr = ((float*)(p.ws + WS_ab))[((size_t)lg * 64 + lane) * 2], abi = ((float*)(p.ws + WS_ab))[((size_t)lg * 64 + lane) * 2 + 1];
  const int ntile = T >> 4;
  bf16x8 am[8];
#pragma unroll
  for (int mt = 0; mt < 8; ++mt) am[mt] = fq < 2 ? ldg8(((u16*)(p.ws + WS_Bmat)) + ((size_t)lg * 128 + mt * 16 + fr) * 16 + fq * 8) : zero8();
  bf16x8 bu4[4];
#pragma unroll
  for (int nt = 0; nt < 4; ++nt) bu4[nt] = (fq < 2 && nt < ntile) ? ldg8(((u16*)(p.ws + WS_U)) + (size_t)(row0 + nt * 16 + fr) * 512 + g * 16 + fq * 8) : zero8();
#pragma unroll
  for (int nt = 0; nt < 4; ++nt) {
    if (nt >= ntile) break;
    const bf16x8 bu = bu4[nt];
#pragma unroll
    for (int mt = 0; mt < 8; ++mt) {
      const f32x4 a = mfma16(am[mt], bu, f32x4{0.f, 0.f, 0.f, 0.f});
      uint2 o; o.x = pack2(a[0], a[1]); o.y = pack2(a[2], a[3]);
      *reinterpret_cast<uint2*>(tile + (nt * 16 + fr) * 136 + mt * 16 + fq * 4) = o;
    }
  }
  wave_lds_sync();
  for (int t = 0; t < T; ++t) {
    const float br = bf2f(tile[t * 136 + lane]), bi = bf2f(tile[t * 136 + 64 + lane]);
    const float nhr = fmaf(abr, hr, fmaf(-abi, hi, br));
    const float nhi = fmaf(abr, hi, fmaf(abi, hr, bi));
    hr = nhr; hi = nhi;
    if (write_y) { tile[t * 136 + lane] = f2bf(hr); tile[t * 136 + 64 + lane] = f2bf(hi); }
  }
  if (!write_y) return;
  wave_lds_sync();
  bf16x8 cm[4];
#pragma unroll
  for (int ks = 0; ks < 4; ++ks) cm[ks] = ldg8(((u16*)(p.ws + WS_Cmat)) + ((size_t)lg * 16 + fr) * 128 + ks * 32 + fq * 8);
  const float dsk = p.d_skip[(size_t)lg * 16 + fr];
  u16 uv[4][4];
#pragma unroll
  for (int mt = 0; mt < 4; ++mt)
#pragma unroll
    for (int j = 0; j < 4; ++j) uv[mt][j] = mt < ntile ? ((u16*)(p.ws + WS_U))[(size_t)(row0 + mt * 16 + fq * 4 + j) * 512 + g * 16 + fr] : (u16)0;
  f32x4 ya[4];
#pragma unroll
  for (int mt = 0; mt < 4; ++mt) {
    f32x4 a = {0.f, 0.f, 0.f, 0.f};
    if (mt < ntile) {
#pragma unroll
      for (int ks = 0; ks < 4; ++ks) a = mfma16(*reinterpret_cast<const bf16x8*>(tile + (mt * 16 + fr) * 136 + ks * 32 + fq * 8), cm[ks], a);
    }
    ya[mt] = a;
  }
#pragma unroll
  for (int mt = 0; mt < 4; ++mt) {
    if (mt < ntile) {
#pragma unroll
      for (int j = 0; j < 4; ++j) {
        u16* up = ((u16*)(p.ws + WS_U)) + (size_t)(row0 + mt * 16 + fq * 4 + j) * 512 + g * 16 + fr;
        const float y = ya[mt][j] + dsk * bf2f(uv[mt][j]);
        *up = f2bf(geluf_(y));
      }
    }
  }
  wave_lds_sync();
}

__device__ void indexer_unit(const Params& p, bool smp, int b, int q0, int nkeys, char* lds) {
  const int tid = tidx(), lane = tid & 63, wave = tid >> 6, fr = lane & 15, fq = lane >> 4;
  constexpr int HROW = 1025;
  uint32_t* hist = reinterpret_cast<uint32_t*>(lds);
  u16* maskbuf = reinterpret_cast<u16*>(lds);
  constexpr int CAP0 = 512;
  uint32_t* candK = reinterpret_cast<uint32_t*>(lds + 16640);
  u16* candP = reinterpret_cast<u16*>(lds + 16640 + 16 * CAP0 * 4);
  uint32_t* s_pref = reinterpret_cast<uint32_t*>(lds + 65792);
  uint32_t* s_need = s_pref + 16;
  uint32_t* s_cnt = s_need + 16;
  uint32_t* s_cn = s_cnt + 16;
  uint32_t* s_flag = s_cn + 16;
  uint32_t* s_cand = s_flag + 16;
  constexpr int CAP = 16;
  constexpr int MB = 520;
  const int Rq0 = smp ? NP + b * 32 + q0 : b * 8192 + q0;
  const u16* KI = smp ? ((u16*)(p.ws + WS_KIs)) + (size_t)b * KIS_ROWS * 64 : ((u16*)(p.ws + WS_KIp)) + (size_t)b * 8192 * 64;
  const int ntiles = nkeys >> 4;

  bf16x8 aq[8][2];
#pragma unroll
  for (int h = 0; h < 8; ++h)
#pragma unroll
    for (int ks = 0; ks < 2; ++ks) aq[h][ks] = ldg8(((u16*)(p.ws + WS_QI)) + (size_t)(Rq0 + fr) * 512 + h * 64 + ks * 32 + fq * 8);
  float w[8];
#pragma unroll
  for (int h = 0; h < 8; ++h) w[h] = ((float*)(p.ws + WS_WI))[(size_t)(Rq0 + fr) * 8 + h];

  bf16x8 nb0 = zero8(), nb1 = zero8();
  auto load_keys = [&](int kt) {
    const u16* kp = KI + (size_t)(kt * 16 + fr) * 64 + fq * 8;
    nb0 = ldg8(kp); nb1 = ldg8(kp + 32);
  };
  auto score_keys = [&](int kt, uint32_t (&key)[4]) {
    const bf16x8 b0 = nb0, b1 = nb1;
    if (kt + 4 < ntiles) load_keys(kt + 4);
    float sc[4] = {0.f, 0.f, 0.f, 0.f};
#pragma unroll
    for (int h = 0; h < 8; ++h) {
      f32x4 a = mfma16h(b0, aq[h][0], f32x4{0.f, 0.f, 0.f, 0.f});
      a = mfma16h(b1, aq[h][1], a);
#pragma unroll
      for (int j = 0; j < 4; ++j) sc[j] = fmaf(w[h], __builtin_amdgcn_fmed3f(a[j], 0.f, 3.0e38f), sc[j]);
    }
#pragma unroll
    for (int j = 0; j < 4; ++j) {
      const uint32_t uu = __float_as_uint(sc[j]);
      key[j] = (uu & 0x80000000u) ? ~uu : (uu | 0x80000000u);
    }
  };

  __syncthreads();
  if (tid < 16) { s_pref[tid] = 0u; s_need[tid] = 256u; s_cn[tid] = 0u; if (tid == 0) { s_flag[0] = 0u; s_flag[1] = 0u; } }
  if (nkeys > 256) {
#pragma unroll 1
    for (int pass = 0; pass < 3; ++pass) {
      if (pass == 1 && s_flag[1] == 0u) break;
      if (pass == 2 && s_flag[0] == 0u) break;
      for (int i = tid; i < 16 * HROW / 4; i += 256) reinterpret_cast<uint4*>(hist)[i] = uint4{0u, 0u, 0u, 0u};
      __syncthreads();
      const uint32_t pref = s_pref[fr];
      const int mshift = pass == 0 ? 32 : (pass == 1 ? 21 : 10);
      const int bshift = pass == 0 ? 21 : (pass == 1 ? 10 : 0);
      const uint32_t bmask = pass == 2 ? 1023u : 2047u;
      if (wave < ntiles) load_keys(wave);
      for (int kt = wave; kt < ntiles; kt += 4) {
        uint32_t key[4];
        score_keys(kt, key);
#pragma unroll
        for (int j = 0; j < 4; ++j) {
          const bool match = pass == 0 ? true : ((key[j] >> mshift) == pref);
          if (match) {
            const uint32_t bin = (key[j] >> bshift) & bmask;
            atomicAdd(&hist[fr * HROW + (bin >> 1)], (bin & 1u) ? 0x10000u : 1u);
          }
        }
      }
      __syncthreads();
      {
        const int q = tid >> 4, part = tid & 15;
        const int nb = pass == 2 ? 1024 : 2048;
        const int per = nb >> 4;
        const uint32_t* hq = hist + q * HROW;
        uint32_t mysum = 0;
        for (int wd = (part * per) >> 1; wd < ((part + 1) * per) >> 1; ++wd) { const uint32_t x = hq[wd]; mysum += (x & 0xffffu) + (x >> 16); }
        uint32_t v = mysum;
#pragma unroll
        for (int d = 1; d < 16; d <<= 1) { const uint32_t t2 = __shfl_down(v, d, 16); if (part + d < 16) v += t2; }
        const uint32_t above = v - mysum;
        const uint32_t need = s_need[q];
        const uint32_t prefq = s_pref[q];
        __syncthreads();
        if (above < need && need <= above + mysum) {
          uint32_t c = above;
          for (int bin = (part + 1) * per - 1; bin >= part * per; --bin) {
            const uint32_t cnt = (hq[bin >> 1] >> ((bin & 1) * 16)) & 0xffffu;
            if (c + cnt >= need) {
              s_pref[q] = (prefq << (pass == 2 ? 10 : 11)) | (uint32_t)bin;
              s_need[q] = need - c;
              if (pass == 1) { s_cnt[q] = cnt; if (cnt > (uint32_t)CAP) s_flag[0] = 1u; }
              if (pass == 0 && cnt > (uint32_t)CAP0) s_flag[1] = 1u;
              break;
            }
            c += cnt;
          }
        }
        __syncthreads();
      }
    }
  } else {
    __syncthreads();
  }
  const bool fast0 = (nkeys > 256) && (s_flag[1] == 0u);
  const bool fast = (nkeys > 256) && !fast0 && (s_flag[0] == 0u);
  const uint32_t thr = s_pref[fr];
  __syncthreads();
  const int nw16 = smp ? 260 : ntiles;
  if (wave < ntiles) load_keys(wave);
  for (int kt = wave; kt < nw16; kt += 4) {
    uint32_t word = 0;
    if (kt < ntiles) {
      uint32_t key[4];
      score_keys(kt, key);
      if (fast0) {
#pragma unroll
        for (int j = 0; j < 4; ++j) {
          const uint32_t k11 = key[j] >> 21;
          word |= (k11 > thr ? 1u : 0u) << (fq * 4 + j);
          if (k11 == thr) {
            const uint32_t ci = atomicAdd(&s_cn[fr], 1u);
            if (ci < (uint32_t)CAP0) { candK[fr * CAP0 + ci] = key[j] & 0x1fffffu; candP[fr * CAP0 + ci] = (u16)(kt * 16 + fq * 4 + j); }
          }
        }
      } else if (fast) {
#pragma unroll
        for (int j = 0; j < 4; ++j) {
          const uint32_t k22 = key[j] >> 10;
          word |= (k22 > thr ? 1u : 0u) << (fq * 4 + j);
          if (k22 == thr) {
            const uint32_t ci = atomicAdd(&s_cn[fr], 1u);
            if (ci < (uint32_t)CAP) s_cand[fr * CAP + ci] = (key[j] & 1023u) | ((uint32_t)(kt * 16 + fq * 4 + j) << 10);
          }
        }
      } else {
#pragma unroll
        for (int j = 0; j < 4; ++j) word |= (key[j] >= thr ? 1u : 0u) << (fq * 4 + j);
      }
      word |= __shfl_xor(word, 16);
      word |= __shfl_xor(word, 32);
    }
    if (fq == 0) maskbuf[fr * MB + kt] = (u16)word;
  }
  __syncthreads();
  if (fast0) {
    const int q = tid >> 4, part = tid & 15;
    const uint32_t n = s_cn[q] < (uint32_t)CAP0 ? s_cn[q] : (uint32_t)CAP0, need = s_need[q];
    uint32_t T = 0;
    for (int bit = 20; bit >= 0; --bit) {
      const uint32_t trial = T | (1u << bit);
      uint32_t c = 0;
      for (uint32_t i = part; i < n; i += 16) c += (candK[q * CAP0 + i] >= trial) ? 1u : 0u;
      c += __shfl_xor(c, 1); c += __shfl_xor(c, 2); c += __shfl_xor(c, 4); c += __shfl_xor(c, 8);
      if (c >= need) T = trial;
    }
    for (uint32_t i = part; i < n; i += 16) {
      if (candK[q * CAP0 + i] >= T) {
        const uint32_t pos = candP[q * CAP0 + i];
        const uint32_t widx = (uint32_t)(q * MB) + (pos >> 4);
        atomicOr(reinterpret_cast<uint32_t*>(maskbuf) + (widx >> 1), (1u << (pos & 15u)) << ((widx & 1u) * 16u));
      }
    }
    __syncthreads();
  }
  if (fast) {
    if (tid < 16) {
      const uint32_t n = s_cn[tid] < (uint32_t)CAP ? s_cn[tid] : (uint32_t)CAP, need = s_need[tid];
      for (uint32_t i = 0; i < n; ++i) {
        const uint32_t ci = s_cand[tid * CAP + i], vi = ci & 1023u;
        uint32_t greater = 0;
        for (uint32_t k = 0; k < n; ++k) greater += ((s_cand[tid * CAP + k] & 1023u) > vi) ? 1u : 0u;
        if (greater < need) {
          const uint32_t pos = ci >> 10;
          maskbuf[tid * MB + (pos >> 4)] |= (u16)(1u << (pos & 15u));
        }
      }
    }
    __syncthreads();
  }
  {
    const int n8 = nw16 >> 2;
    for (int i = tid; i < 16 * n8; i += 256) {
      const int q = i / n8, c = i % n8;
      const uint2 vv = *reinterpret_cast<const uint2*>(maskbuf + q * MB + c * 4);
      u16* dst = smp ? ((u16*)(p.ws + WS_masks)) + (size_t)(b * 32 + q0 + q) * MS_ROW : ((u16*)(p.ws + WS_maskp)) + (size_t)(b * 8192 + q0 + q) * 512;
      *reinterpret_cast<uint2*>(dst + c * 4) = vv;
    }
  }
}

__device__ void ssm_local_scan(const Params& p, int l, int b, int c, int g) {
  const int lane = tidx() & 63;
  const int lg = l * 32 + g;
  const float abr = ((float*)(p.ws + WS_ab))[((size_t)lg * 64 + lane) * 2], abi = ((float*)(p.ws + WS_ab))[((size_t)lg * 64 + lane) * 2 + 1];
  float bbr[16], bbi[16];
#pragma unroll
  for (int n = 0; n < 16; ++n) {
    bbr[n] = ((float*)(p.ws + WS_BbF))[(((size_t)lg * 2 + 0) * 16 + n) * 64 + lane];
    bbi[n] = ((float*)(p.ws + WS_BbF))[(((size_t)lg * 2 + 1) * 16 + n) * 64 + lane];
  }
  float hr = 0.f, hi = 0.f;
  const u16* up = ((u16*)(p.ws + WS_U)) + ((size_t)b * 8192 + (size_t)c * 64) * 512 + g * 16;
  u32x4 cur[8], nxt[8];
#pragma unroll
  for (int k = 0; k < 4; ++k) {
    cur[2 * k] = *reinterpret_cast<const u32x4*>(up + (size_t)k * 512);
    cur[2 * k + 1] = *reinterpret_cast<const u32x4*>(up + (size_t)k * 512 + 8);
  }
  for (int t4 = 0; t4 < 16; ++t4) {
    if (t4 + 1 < 16) {
#pragma unroll
      for (int k = 0; k < 4; ++k) {
        nxt[2 * k] = *reinterpret_cast<const u32x4*>(up + (size_t)((t4 + 1) * 4 + k) * 512);
        nxt[2 * k + 1] = *reinterpret_cast<const u32x4*>(up + (size_t)((t4 + 1) * 4 + k) * 512 + 8);
      }
    }
#pragma unroll
    for (int k = 0; k < 4; ++k) {
      float br = 0.f, bi = 0.f;
#pragma unroll
      for (int h2 = 0; h2 < 2; ++h2) {
        const u32x4 w = cur[2 * k + h2];
#pragma unroll
        for (int d = 0; d < 4; ++d) {
          const float x0 = __uint_as_float(w[d] << 16), x1 = __uint_as_float(w[d] & 0xffff0000u);
          const int n = h2 * 8 + d * 2;
          br = fmaf(bbr[n], x0, br); bi = fmaf(bbi[n], x0, bi);
          br = fmaf(bbr[n + 1], x1, br); bi = fmaf(bbi[n + 1], x1, bi);
        }
      }
      const float nhr = fmaf(abr, hr, fmaf(-abi, hi, br));
      const float nhi = fmaf(abr, hi, fmaf(abi, hr, bi));
      hr = nhr; hi = nhi;
    }
#pragma unroll
    for (int k = 0; k < 8; ++k) cur[k] = nxt[k];
  }
  const size_t o = ((size_t)(b * 128 + c) * 32 + g) * 64 + lane;
  ((float*)(p.ws + WS_SlocR))[o] = hr; ((float*)(p.ws + WS_SlocI))[o] = hi;
}

__device__ void phase_ssmA_indexer(const Params& p, int l, char* lds) {
  const int wave = tidx() >> 6;
  const int x = blockIdx.x & 7, j = blockIdx.x >> 3, nb = gridDim.x >> 3;
  if (blockIdx.x < 32) indexer_unit(p, true, blockIdx.x >> 1, (blockIdx.x & 1) * 16, 4128, lds);
  for (int tlo = j; tlo < 256; tlo += nb) {
    const int th = 511 - tlo;
    indexer_unit(p, false, x, th * 16, ((th >> 2) + 1) * 64, lds);
    indexer_unit(p, false, x, tlo * 16, ((tlo >> 2) + 1) * 64, lds);
  }
  for (int u = blockIdx.x; u < 8192; u += gridDim.x) {
    const int wu = u * 4 + wave;
    ssm_local_scan(p, l, wu >> 12, (wu >> 5) & 127, wu & 31);
  }
}

DI bf16x8 pack8_bf16(float a0, float a1, float a2, float a3, float a4, float a5, float a6, float a7) {
  u32x4 r;
  asm("v_cvt_pk_bf16_f32 %0, %4, %5\n\tv_cvt_pk_bf16_f32 %1, %6, %7\n\tv_cvt_pk_bf16_f32 %2, %8, %9\n\tv_cvt_pk_bf16_f32 %3, %10, %11\n\ts_nop 1"
      : "=&v"(r[0]), "=&v"(r[1]), "=&v"(r[2]), "=&v"(r[3])
      : "v"(a0), "v"(a1), "v"(a2), "v"(a3), "v"(a4), "v"(a5), "v"(a6), "v"(a7));
  return __builtin_bit_cast(bf16x8, r);
}

__device__ void attn_unit(const Params& p, bool smp, int b, int chunk, int h, char* lds) {
  constexpr int LR = 72;
  constexpr int STG = 128 * LR;
  const int tid = tidx(), lane = tid & 63, wave = tid >> 6, fr = lane & 15, fq = lane >> 4;
  u16* sbase = reinterpret_cast<u16*>(lds);
  const int nq = smp ? 32 : 64;
  const int nkeys = smp ? 4128 : 64 * (chunk + 1);
  const int ntile = (nkeys + 63) >> 6;
  const int Rq0 = smp ? NP + b * 32 : b * 8192 + chunk * 64;
  const u16* Kb = (smp ? ((u16*)(p.ws + WS_Ks)) + (size_t)b * KS_ROWS * 512 : ((u16*)(p.ws + WS_Kp)) + (size_t)b * 8192 * 512) + h * 64;
  const int Sv = smp ? KS_ROWS : 8192;
  const u16* Vb = smp ? ((u16*)(p.ws + WS_VTs)) + ((size_t)b * 512 + h * 64) * KS_ROWS : ((u16*)(p.ws + WS_VTp)) + ((size_t)b * 512 + h * 64) * 8192;
  const bool active = wave * 16 < nq;
  const int qrow = active ? wave * 16 : 0;
  bf16x8 aq[2];
#pragma unroll
  for (int ks = 0; ks < 2; ++ks) aq[ks] = ldg8(((u16*)(p.ws + WS_Q)) + (size_t)(Rq0 + qrow + fr) * 512 + h * 64 + ks * 32 + fq * 8);
  const u16* mrow = smp ? ((u16*)(p.ws + WS_masks)) + (size_t)(b * 32 + qrow + fr) * MS_ROW
                        : ((u16*)(p.ws + WS_maskp)) + (size_t)(b * 8192 + chunk * 64 + qrow + fr) * 512;
  const int srow = tid >> 3, sch = tid & 7;
  u32x4 rk[2], rv[2];
  u32x2 mk;
  auto gload = [&](int kt) {
#pragma unroll
    for (int i = 0; i < 2; ++i) {
      rk[i] = *reinterpret_cast<const u32x4*>(Kb + (size_t)(kt * 64 + srow + i * 32) * 512 + sch * 8);
      rv[i] = *reinterpret_cast<const u32x4*>(Vb + (size_t)(srow + i * 32) * Sv + kt * 64 + sch * 8);
    }
    mk = *reinterpret_cast<const u32x2*>(mrow + kt * 4);
  };
  auto lstore = [&](int buf) {
    u16* sK = sbase + buf * STG;
    u16* sV = sK + 64 * LR;
#pragma unroll
    for (int i = 0; i < 2; ++i) {
      *reinterpret_cast<u32x4*>(sK + (srow + i * 32) * LR + sch * 8) = rk[i];
      *reinterpret_cast<u32x4*>(sV + (srow + i * 32) * LR + sch * 8) = rv[i];
    }
  };
  f32x4 Ot[4];
#pragma unroll
  for (int n = 0; n < 4; ++n) Ot[n] = f32x4{0.f, 0.f, 0.f, 0.f};
  float mrun = -1e29f, lrun = 0.f;
  gload(0);
  __syncthreads();
  lstore(0);
  u32x2 mcur = mk;
  if (ntile > 1) gload(1);
  __syncthreads();
  for (int kt = 0; kt < ntile; ++kt) {
    const int cur = kt & 1;
    const u32x2 mthis = mcur;
    if (kt + 1 < ntile) { lstore(cur ^ 1); mcur = mk; }
    if (kt + 2 < ntile) gload(kt + 2);
    if (active) {
      const u16* sK = sbase + cur * STG;
      const u16* sV = sK + 64 * LR;
      f32x4 st[4];
#pragma unroll
      for (int n = 0; n < 4; ++n) {
        f32x4 a = {0.f, 0.f, 0.f, 0.f};
#pragma unroll
        for (int ks = 0; ks < 2; ++ks) a = mfma16(*reinterpret_cast<const bf16x8*>(sK + (n * 16 + fr) * LR + ks * 32 + fq * 8), aq[ks], a);
        st[n] = a;
      }
      float mx = -1e30f;
#pragma unroll
      for (int n = 0; n < 4; ++n) {
        const uint32_t nib = ((n < 2 ? mthis[0] : mthis[1]) >> ((n & 1) * 16 + fq * 4)) & 15u;
#pragma unroll
        for (int j = 0; j < 4; ++j) {
          st[n][j] = (nib & (1u << j)) ? st[n][j] : -1e30f;
          mx = fmaxf(mx, st[n][j]);
        }
      }
      mx = fmaxf(mx, __shfl_xor(mx, 16));
      mx = fmaxf(mx, __shfl_xor(mx, 32));
      const float mnew = fmaxf(mrun, mx);
      const float alpha = __builtin_amdgcn_exp2f(mrun - mnew);
      mrun = mnew;
      float ps = 0.f;
#pragma unroll
      for (int n = 0; n < 4; ++n)
#pragma unroll
        for (int j = 0; j < 4; ++j) { st[n][j] = __builtin_amdgcn_exp2f(st[n][j] - mnew); ps += st[n][j]; }
      lrun = lrun * alpha + ps;
#pragma unroll
      for (int n = 0; n < 4; ++n)
#pragma unroll
        for (int j = 0; j < 4; ++j) Ot[n][j] *= alpha;
#pragma unroll
      for (int ks = 0; ks < 2; ++ks) {
        const bf16x8 pb = pack8_bf16(st[2 * ks][0], st[2 * ks][1], st[2 * ks][2], st[2 * ks][3],
                                     st[2 * ks + 1][0], st[2 * ks + 1][1], st[2 * ks + 1][2], st[2 * ks + 1][3]);
#pragma unroll
        for (int dt = 0; dt < 4; ++dt) {
          const u16* vr = sV + (dt * 16 + fr) * LR + ks * 32 + fq * 4;
          const u32x2 v0 = *reinterpret_cast<const u32x2*>(vr), v1 = *reinterpret_cast<const u32x2*>(vr + 16);
          const u32x4 vv = {v0[0], v0[1], v1[0], v1[1]};
          Ot[dt] = mfma16(__builtin_bit_cast(bf16x8, vv), pb, Ot[dt]);
        }
      }
    }
    __syncthreads();
  }
  if (active) {
    float ls = lrun;
    ls += __shfl_xor(ls, 16); ls += __shfl_xor(ls, 32);
    const float inv = 1.f / ls;
    const size_t ro = (size_t)(Rq0 + qrow + fr) * 512 + h * 64;
    u32x2 zz4[4];
#pragma unroll
    for (int dt = 0; dt < 4; ++dt) zz4[dt] = *reinterpret_cast<const u32x2*>(((u16*)(p.ws + WS_ZA)) + ro + dt * 16 + fq * 4);
#pragma unroll
    for (int dt = 0; dt < 4; ++dt) {
      const size_t o = ro + dt * 16 + fq * 4;
      const u32x2 zz = zz4[dt];
      const float z0 = __uint_as_float(zz[0] << 16), z1 = __uint_as_float(zz[0] & 0xffff0000u);
      const float z2 = __uint_as_float(zz[1] << 16), z3 = __uint_as_float(zz[1] & 0xffff0000u);
      u32x2 ov;
      ov[0] = pack2(Ot[dt][0] * inv * z0, Ot[dt][1] * inv * z1);
      ov[1] = pack2(Ot[dt][2] * inv * z2, Ot[dt][3] * inv * z3);
      *reinterpret_cast<u32x2*>(((u16*)(p.ws + WS_Q)) + o) = ov;
    }
  }
}

__device__ void phase_ssmB_attn(const Params& p, int l, char* lds) {
  const int x = blockIdx.x & 7, j = blockIdx.x >> 3, nb = gridDim.x >> 3;
  if (blockIdx.x >= gridDim.x - 64) {
    const int t = (gridDim.x - 1 - blockIdx.x) * 256 + tidx();
    const int pp = t & 63, g = (t >> 6) & 31, b = t >> 11;
    float ar = ((float*)(p.ws + WS_ab))[((size_t)(l * 32 + g) * 64 + pp) * 2], ai = ((float*)(p.ws + WS_ab))[((size_t)(l * 32 + g) * 64 + pp) * 2 + 1];
#pragma unroll
    for (int i = 0; i < 6; ++i) { const float nr = ar * ar - ai * ai, ni = 2.f * ar * ai; ar = nr; ai = ni; }
    float hr = 0.f, hi = 0.f;
    for (int c8 = 0; c8 < 128; c8 += 8) {
      float sr[8], si[8];
#pragma unroll
      for (int k = 0; k < 8; ++k) {
        const size_t o = ((size_t)(b * 128 + c8 + k) * 32 + g) * 64 + pp;
        sr[k] = ((float*)(p.ws + WS_SlocR))[o]; si[k] = ((float*)(p.ws + WS_SlocI))[o];
      }
#pragma unroll
      for (int k = 0; k < 8; ++k) {
        const size_t o = ((size_t)(b * 128 + c8 + k) * 32 + g) * 64 + pp;
        ((float*)(p.ws + WS_HstR))[o] = hr; ((float*)(p.ws + WS_HstI))[o] = hi;
        const float nhr = ar * hr - ai * hi + sr[k], nhi = ar * hi + ai * hr + si[k];
        hr = nhr; hi = nhi;
      }
    }
    p.out[O_SRP + (size_t)l * 16384 + (size_t)(b * 32 + g) * 64 + pp] = hr;
    p.out[O_SIP + (size_t)l * 16384 + (size_t)(b * 32 + g) * 64 + pp] = hi;
  }
  if (blockIdx.x < 128) attn_unit(p, true, blockIdx.x >> 3, 0, blockIdx.x & 7, lds);
  for (int pi = 0; pi < 8; ++pi) {
    const int pair = x + 8 * pi, b = pair >> 3, h = pair & 7;
    for (int c = j; c < 64; c += nb) {
      attn_unit(p, false, b, 127 - c, h, lds);
      attn_unit(p, false, b, c, h, lds);
    }
  }
}

__device__ void phase_ssmC(const Params& p, int l, char* lds) {
  const int wave = tidx() >> 6, lane = tidx() & 63;
  const int NU = (32768 + 512) / 4;
  for (int u = blockIdx.x; u < NU; u += gridDim.x) {
    const int wu = u * 4 + wave;
    u16* tile = reinterpret_cast<u16*>(lds) + wave * (64 * 136);
    if (wu < 32768) {
      const int g = wu & 31, c = (wu >> 5) & 127, b = wu >> 12;
      const size_t o = ((size_t)(b * 128 + c) * 32 + g) * 64 + lane;
      float hr = ((float*)(p.ws + WS_HstR))[o], hi = ((float*)(p.ws + WS_HstI))[o];
      ssm_unit(p, l, g, b * 8192 + c * 64, 64, hr, hi, true, tile);
    } else {
      const int i = wu - 32768;
      const int g = i & 31, b = i >> 5;
      const size_t si = ((size_t)(l * 16 + b) * 32 + g) * 64 + lane;
      float hr = p.st_re[si], hi = p.st_im[si];
      ssm_unit(p, l, g, NP + b * 32, 32, hr, hi, true, tile);
      p.out[O_SRS + si] = hr;
      p.out[O_SIS + si] = hi;
    }
  }
}

__device__ void phase_glu(const Params& p, int l, char* lds) {
  const int lane = tidx() & 63, wave = tidx() >> 6, wr = wave >> 1, wc = wave & 1, fr = lane & 15, fq = lane >> 4;
  GemmOrder ord; ord.init(NTOK / 128, 4);
  int mt, nt;
  while (ord.next(mt, nt)) {
    f32x4 acc[4][4];
    zero_acc<4>(acc);
    gemm_accum<4>(acc, ((u16*)(p.ws + WS_U)) + (size_t)mt * 128 * 512, 512, ((u16*)(p.ws + WS_WgluT)) + ((size_t)l * 512 + nt * 128) * 512, 512, 512, reinterpret_cast<u16*>(lds));
    float bg[4];
#pragma unroll
    for (int n = 0; n < 4; ++n) bg[n] = p.b_glu[l * 512 + nt * 128 + wc * 64 + n * 16 + fr];
#pragma unroll
    for (int m = 0; m < 4; ++m) {
      u16 yv[4][4], zv[4][4];
#pragma unroll
      for (int n = 0; n < 4; ++n)
#pragma unroll
        for (int j = 0; j < 4; ++j) {
          const size_t o = (size_t)(mt * 128 + wr * 64 + m * 16 + fq * 4 + j) * 512 + nt * 128 + wc * 64 + n * 16 + fr;
          yv[n][j] = ((u16*)(p.ws + WS_U))[o];
          zv[n][j] = ((u16*)(p.ws + WS_ZS))[o];
        }
#pragma unroll
      for (int n = 0; n < 4; ++n)
#pragma unroll
        for (int j = 0; j < 4; ++j) {
          const size_t o = (size_t)(mt * 128 + wr * 64 + m * 16 + fq * 4 + j) * 512 + nt * 128 + wc * 64 + n * 16 + fr;
          ((u16*)(p.ws + WS_ZS))[o] = f2bf(bf2f(yv[n][j]) * sigmoidf_(acc[m][n][j] + bg[n]) * bf2f(zv[n][j]));
        }
    }
  }
}
__device__ void phase_merge(const Params& p, int l, char* lds) {
  const int lane = tidx() & 63, wave = tidx() >> 6, wr = wave >> 1, wc = wave & 1, fr = lane & 15, fq = lane >> 4;
  u16* L = reinterpret_cast<u16*>(lds);
  GemmOrder ord; ord.init(NTOK / 128, 16);
  int mt, nt;
  while (ord.next(mt, nt)) {
    f32x4 G[4][4];
    zero_acc<4>(G);
    gemm_accum<4, true>(G, ((u16*)(p.ws + WS_H)) + (size_t)mt * 128 * 1024, 1024, ((u16*)(p.ws + WS_WgT)) + ((size_t)l * 2048 + nt * 128) * 1024, 1024, 1024, L);
#pragma unroll
    for (int m = 0; m < 4; ++m)
#pragma unroll
      for (int n = 0; n < 4; ++n)
#pragma unroll
        for (int j = 0; j < 4; ++j) G[m][n][j] = sigmoidf_(G[m][n][j]);
    f32x4 acc[4][2];
    zero_acc<2>(acc);
    gemm_accum<2>(acc, ((u16*)(p.ws + WS_ZS)) + (size_t)mt * 128 * 512, 512, ((u16*)(p.ws + WS_WpsT)) + ((size_t)l * 1024 + nt * 64) * 512, 512, 512, L);
#pragma unroll
    for (int m = 0; m < 4; ++m)
#pragma unroll
      for (int n = 0; n < 2; ++n)
#pragma unroll
        for (int j = 0; j < 4; ++j) G[m][n][j] *= acc[m][n][j];
    zero_acc<2>(acc);
    gemm_accum<2>(acc, ((u16*)(p.ws + WS_Q)) + (size_t)mt * 128 * 512, 512, ((u16*)(p.ws + WS_WpaT)) + ((size_t)l * 1024 + nt * 64) * 512, 512, 512, L);
#pragma unroll
    for (int m = 0; m < 4; ++m)
#pragma unroll
      for (int n = 0; n < 2; ++n) {
        const int C = nt * 64 + wc * 32 + n * 16 + fr;
#pragma unroll
        for (int j = 0; j < 4; ++j) {
          const float v = G[m][n][j] + G[m][n + 2][j] * acc[m][n][j];
          ((u16*)(p.ws + WS_U))[(size_t)(mt * 128 + wr * 64 + m * 16 + fq * 4 + j) * 1024 + C] = f2bf(v);
        }
      }
  }
}

__device__ void phase_out(const Params& p, int l, char* lds) {
  const int lane = tidx() & 63, wave = tidx() >> 6, wr = wave >> 1, wc = wave & 1, fr = lane & 15, fq = lane >> 4;
  GemmOrder ord; ord.init(NTOK / 128, 8);
  int mt, nt;
  while (ord.next(mt, nt)) {
    f32x4 acc[4][4];
    zero_acc<4>(acc);
    gemm_accum<4>(acc, ((u16*)(p.ws + WS_U)) + (size_t)mt * 128 * 1024, 1024, ((u16*)(p.ws + WS_WoT)) + ((size_t)l * 1024 + nt * 128) * 1024, 1024, 1024, reinterpret_cast<u16*>(lds));
    float xo[4][4][4];
#pragma unroll
    for (int m = 0; m < 4; ++m) {
      const int R0 = mt * 128 + wr * 64 + m * 16 + fq * 4;
#pragma unroll
      for (int j = 0; j < 4; ++j) {
        const float* xr = xin_row(p, l, R0 + j) + nt * 128 + wc * 64 + fr;
#pragma unroll
        for (int n = 0; n < 4; ++n) xo[m][n][j] = xr[n * 16];
      }
    }
#pragma unroll
    for (int m = 0; m < 4; ++m) {
      const int R0 = mt * 128 + wr * 64 + m * 16 + fq * 4;
      const float* gate = ((float*)(p.ws + WS_mod)) + ((size_t)l * 24 + batch_of(R0)) * 3072 + 2048;
#pragma unroll
      for (int n = 0; n < 4; ++n) {
        const int C = nt * 128 + wc * 64 + n * 16 + fr;
        const float gv = gate[C];
#pragma unroll
        for (int j = 0; j < 4; ++j) p.out[(size_t)(R0 + j) * 1024 + C] = xo[m][n][j] + gv * acc[m][n][j];
      }
    }
  }
}

__device__ void phase_final(const Params& p) {
  const int wave = tidx() >> 6, lane = tidx() & 63;
  const int gw = blockIdx.x * 4 + wave, nw = gridDim.x * 4;
  for (int R = gw; R < NTOK; R += nw) {
    float* x = p.out + (size_t)R * 1024;
    float4 v[4];
    float ss = 0.f;
#pragma unroll
    for (int i = 0; i < 4; ++i) {
      v[i] = *reinterpret_cast<const float4*>(x + i * 256 + lane * 4);
      ss += v[i].x * v[i].x + v[i].y * v[i].y + v[i].z * v[i].z + v[i].w * v[i].w;
    }
    ss = wave_sum(ss);
    const float rstd = rsqrtf(ss * (1.f / 1024.f) + 1e-6f);
#pragma unroll
    for (int i = 0; i < 4; ++i) {
      const int c = i * 256 + lane * 4;
      const float4 g4 = *reinterpret_cast<const float4*>(p.g_final + c);
      float4 o;
      o.x = v[i].x * rstd * g4.x; o.y = v[i].y * rstd * g4.y; o.z = v[i].z * rstd * g4.z; o.w = v[i].w * rstd * g4.w;
      *reinterpret_cast<float4*>(x + c) = o;
    }
  }
}

__global__ void __launch_bounds__(256, 2) fwd_megakernel(Params p) {
  extern __shared__ __attribute__((aligned(16))) char lds[];
  cg::grid_group grid = cg::this_grid();
  for (int ph = p.phase_lo; ph <= p.phase_hi; ++ph) {
    if (ph > p.phase_lo) grid.sync();
    Params q = p;
#define LAUNDER(f) asm volatile("" : "+s"(q.f))
    LAUNDER(x_prompt); LAUNDER(x_sample); LAUNDER(cache_k); LAUNDER(cache_v); LAUNDER(cache_kidx); LAUNDER(st_re); LAUNDER(st_im);
    LAUNDER(c_prompt); LAUNDER(c_sample); LAUNDER(w_mod); LAUNDER(b_mod); LAUNDER(g_norm); LAUNDER(w_in); LAUNDER(a_re); LAUNDER(a_im);
    LAUNDER(log_dt); LAUNDER(b_re); LAUNDER(b_im); LAUNDER(c_re); LAUNDER(c_im); LAUNDER(d_skip); LAUNDER(w_glu); LAUNDER(b_glu);
    LAUNDER(w_ps); LAUNDER(w_pa); LAUNDER(w_o); LAUNDER(g_final); LAUNDER(out); LAUNDER(ws);
#undef LAUNDER
    if (ph == 0) phase_prep(q, lds);
    else if (ph == NPHASE - 1) phase_final(q);
    else {
      const int l = (ph - 1) >> 3, s = (ph - 1) & 7;
      switch (s) {
        case 0: phase_norm(q, l); break;
        case 1: phase_inproj(q, l, lds); break;
        case 2: phase_ssmA_indexer(q, l, lds); break;
        case 3: phase_ssmB_attn(q, l, lds); break;
        case 4: phase_ssmC(q, l, lds); break;
        case 5: phase_glu(q, l, lds); break;
        case 6: phase_merge(q, l, lds); break;
        default: phase_out(q, l, lds); break;
      }
    }
  }
}

extern "C" void kernel_launch(void* const* d_in, const int* in_sizes, int n_in, void* d_out, int out_size, void* d_ws, size_t ws_size,
                              hipStream_t stream) {
  static int grid_blocks = 0;
  if (!grid_blocks) {
    int dev = 0, cus = 0, per_cu = 0;
    hipGetDevice(&dev);
    hipDeviceGetAttribute(&cus, hipDeviceAttributeMultiprocessorCount, dev);
    hipFuncSetAttribute((const void*)fwd_megakernel, hipFuncAttributeMaxDynamicSharedMemorySize, LDS_BYTES);
    hipOccupancyMaxActiveBlocksPerMultiprocessor(&per_cu, (const void*)fwd_megakernel, 256, LDS_BYTES);
    if (per_cu < 1) per_cu = 1;
    if (per_cu > 2) per_cu = 2;
    grid_blocks = cus * per_cu;
  }
  Params p{};
  const float* const* in = reinterpret_cast<const float* const*>(d_in);
  p.x_prompt = in[0]; p.x_sample = in[1]; p.cache_k = in[2]; p.cache_v = in[3]; p.cache_kidx = in[4];
  p.st_re = in[5]; p.st_im = in[6]; p.c_prompt = in[7]; p.c_sample = in[8];
  p.w_mod = in[9]; p.b_mod = in[10]; p.g_norm = in[11]; p.w_in = in[12]; p.a_re = in[13]; p.a_im = in[14]; p.log_dt = in[15];
  p.b_re = in[16]; p.b_im = in[17]; p.c_re = in[18]; p.c_im = in[19]; p.d_skip = in[20];
  p.w_glu = in[21]; p.b_glu = in[22]; p.w_ps = in[23]; p.w_pa = in[24]; p.w_o = in[25]; p.g_final = in[26];
  p.out = (float*)d_out;
  p.ws = (char*)d_ws;
  if (WS_TOTAL > ws_size) fprintf(stderr, "kernel_launch: workspace too small: need %zu have %zu\n", (size_t)WS_TOTAL, ws_size);
#if MULTI_LAUNCH
  for (int ph = 0; ph < NPHASE; ++ph) {
    p.phase_lo = ph; p.phase_hi = ph;
    hipLaunchKernelGGL(fwd_megakernel, dim3(grid_blocks), dim3(256), LDS_BYTES, stream, p);
  }
#else
  p.phase_lo = 0; p.phase_hi = NPHASE - 1;
  void* args[] = {&p};
  hipError_t e = hipLaunchCooperativeKernel((void*)fwd_megakernel, dim3(grid_blocks), dim3(256), args, LDS_BYTES, stream);
  if (e != hipSuccess) fprintf(stderr, "cooperative launch failed: %s (grid %d)\n", hipGetErrorString(e), grid_blocks);
#endif
}
```

```cpp
#include <hip/hip_runtime.h>
#include <hip/hip_cooperative_groups.h>
#include <stdint.h>
#include <stdio.h>
namespace cg = cooperative_groups;

#ifndef MULTI_LAUNCH
#define MULTI_LAUNCH 0
#endif

#define DI __device__ __forceinline__
typedef __attribute__((ext_vector_type(8))) short bf16x8;
typedef __attribute__((ext_vector_type(4))) float f32x4;
typedef unsigned short u16;
typedef __attribute__((ext_vector_type(4))) unsigned u32x4;
typedef __attribute__((ext_vector_type(2))) unsigned u32x2;

constexpr int NP = 65536, NS = 512, NTOK = NP + NS;
constexpr int D_IN = 5704, N_IN1 = 3656, N_IN1P = 3712;
constexpr int KS_ROWS = 4160, KIS_ROWS = 4128, MS_ROW = 264;
constexpr int LDS_BYTES = 73728;
constexpr int NPHASE = 18;

constexpr size_t O_KP = 67633152, O_VP = 134742016, O_KIP = 201850880, O_SRP = 210239488, O_SIP = 210272256,
                 O_KS = 210305024, O_VS = 210829312, O_KIS = 211353600, O_SRS = 211419136, O_SIS = 211484672;

struct Params {
  const float *x_prompt, *x_sample, *cache_k, *cache_v, *cache_kidx, *st_re, *st_im, *c_prompt, *c_sample;
  const float *w_mod, *b_mod, *g_norm, *w_in, *a_re, *a_im, *log_dt, *b_re, *b_im, *c_re, *c_im, *d_skip;
  const float *w_glu, *b_glu, *w_ps, *w_pa, *w_o, *g_final;
  float* out;
  char* ws;
  int phase_lo, phase_hi;
};
constexpr size_t al256(size_t x) { return (x + 255) & ~(size_t)255; }
constexpr size_t WS_WinT = 0;
constexpr size_t WS_WgT = WS_WinT + al256((size_t)2 * N_IN1P * 1024 * 2);
constexpr size_t WS_WgluT = WS_WgT + al256((size_t)2 * 2048 * 1024 * 2);
constexpr size_t WS_WpsT = WS_WgluT + al256((size_t)2 * 512 * 512 * 2);
constexpr size_t WS_WpaT = WS_WpsT + al256((size_t)2 * 1024 * 512 * 2);
constexpr size_t WS_WoT = WS_WpaT + al256((size_t)2 * 1024 * 512 * 2);
constexpr size_t WS_mod = WS_WoT + al256((size_t)2 * 1024 * 1024 * 2);
constexpr size_t WS_ab = WS_mod + al256((size_t)2 * 24 * 3072 * 4);
constexpr size_t WS_Bmat = WS_ab + al256((size_t)2 * 32 * 64 * 2 * 4);
constexpr size_t WS_Cmat = WS_Bmat + al256((size_t)2 * 32 * 128 * 16 * 2);
constexpr size_t WS_H = WS_Cmat + al256((size_t)2 * 32 * 16 * 128 * 2);
constexpr size_t WS_U = WS_H + al256((size_t)NTOK * 1024 * 2);
constexpr size_t WS_QI = WS_U + (size_t)NTOK * 512 * 2;
constexpr size_t WS_ZS = WS_QI + al256((size_t)NTOK * 512 * 2);
constexpr size_t WS_Q = WS_ZS + al256((size_t)NTOK * 512 * 2);
constexpr size_t WS_ZA = WS_Q + al256((size_t)NTOK * 512 * 2);
constexpr size_t WS_Kp = WS_ZA + al256((size_t)NTOK * 512 * 2);
constexpr size_t WS_VTp = WS_Kp + al256((size_t)NP * 512 * 2);
constexpr size_t WS_KIp = WS_VTp + al256((size_t)NP * 512 * 2);
constexpr size_t WS_Ks = WS_KIp + al256((size_t)NP * 64 * 2);
constexpr size_t WS_VTs = WS_Ks + al256((size_t)16 * KS_ROWS * 512 * 2);
constexpr size_t WS_KIs = WS_VTs + al256((size_t)16 * 512 * KS_ROWS * 2);
constexpr size_t WS_WI = WS_KIs + al256((size_t)16 * KIS_ROWS * 64 * 2);
constexpr size_t WS_SlocR = WS_WI + al256((size_t)NTOK * 8 * 4);
constexpr size_t WS_SlocI = WS_SlocR + al256((size_t)8 * 128 * 32 * 64 * 4);
constexpr size_t WS_HstR = WS_SlocI + al256((size_t)8 * 128 * 32 * 64 * 4);
constexpr size_t WS_HstI = WS_HstR + al256((size_t)8 * 128 * 32 * 64 * 4);
constexpr size_t WS_maskp = WS_HstI + al256((size_t)8 * 128 * 32 * 64 * 4);
constexpr size_t WS_masks = WS_maskp + al256((size_t)NP * 512 * 2);
constexpr size_t WS_BbF = WS_masks + al256((size_t)NS * MS_ROW * 2);
constexpr size_t WS_TOTAL = WS_BbF + al256((size_t)64 * 2 * 16 * 64 * 4);

DI u16 f2bf(float x) { uint32_t u = __float_as_uint(x); u += 0x7fffu + ((u >> 16) & 1u); return (u16)(u >> 16); }
DI float bf2f(u16 h) { return __uint_as_float(((uint32_t)h) << 16); }
DI uint32_t pack2(float a, float b) { return (uint32_t)f2bf(a) | ((uint32_t)f2bf(b) << 16); }
DI float sigmoidf_(float x) { return 1.f / (1.f + __expf(-x)); }
DI float siluf_(float x) { return x * sigmoidf_(x); }
DI float geluf_(float v) { return v * sigmoidf_(1.5957691216f * (v + 0.044715f * v * v * v)); }
DI float wave_sum(float v) {
#pragma unroll
  for (int o = 32; o > 0; o >>= 1) v += __shfl_xor(v, o);
  return v;
}
DI int tidx() { int t = threadIdx.x; asm volatile("" : "+v"(t)); return t; }
DI void wave_lds_sync() { asm volatile("s_waitcnt lgkmcnt(0)" ::: "memory"); }
DI f32x4 mfma16(bf16x8 a, bf16x8 b, f32x4 c) { return __builtin_amdgcn_mfma_f32_16x16x32_bf16(a, b, c, 0, 0, 0); }
typedef _Float16 f16x8 __attribute__((ext_vector_type(8)));
DI f32x4 mfma16h(bf16x8 a, bf16x8 b, f32x4 c) { return __builtin_amdgcn_mfma_f32_16x16x32_f16(__builtin_bit_cast(f16x8, a), __builtin_bit_cast(f16x8, b), c, 0, 0, 0); }
DI u16 f2h(float x) { const _Float16 h = (_Float16)x; return __builtin_bit_cast(u16, h); }
DI uint32_t pack2h(float a, float b) { return (uint32_t)f2h(a) | ((uint32_t)f2h(b) << 16); }
DI bf16x8 ldg8(const u16* p) { return *reinterpret_cast<const bf16x8*>(p); }
DI bf16x8 zero8() { bf16x8 z = {0, 0, 0, 0, 0, 0, 0, 0}; return z; }

DI const float* xin_row(const Params& p, int l, int R) {
  if (l == 0) return R < NP ? p.x_prompt + (size_t)R * 1024 : p.x_sample + (size_t)(R - NP) * 1024;
  return p.out + (size_t)R * 1024;
}
DI int batch_of(int R) { return R < NP ? (R >> 13) : 8 + ((R - NP) >> 5); }

template <int NT, bool F16 = false>
DI void gemm_accum(f32x4 (&acc)[4][NT], const u16* __restrict__ A, int lda, const u16* __restrict__ Bt, int ldb, int K, u16* lds) {
  constexpr int LR = 72;
  constexpr int BN = 32 * NT;
  constexpr int NBCH = BN / 32;
  constexpr int BUF = 256 * LR;
  const int tid = tidx(), lane = tid & 63, wave = tid >> 6, wr = wave >> 1, wc = wave & 1, fr = lane & 15, fq = lane >> 4;
  u32x4 ra[4], rb[NBCH];
  const int crow = tid >> 3, cch = tid & 7;
  const u16* Ap = A + (size_t)crow * lda + cch * 8;
  const u16* Bp = Bt + (size_t)crow * ldb + cch * 8;
  const int nk = K >> 6;
  auto gload = [&](int kt) {
    const int k0 = kt << 6;
#pragma unroll
    for (int i = 0; i < 4; ++i) ra[i] = *reinterpret_cast<const u32x4*>(Ap + (size_t)(i * 32) * lda + k0);
#pragma unroll
    for (int i = 0; i < NBCH; ++i) rb[i] = *reinterpret_cast<const u32x4*>(Bp + (size_t)(i * 32) * ldb + k0);
  };
  auto lstore = [&](int buf) {
    u16* sA = lds + buf * BUF;
    u16* sB = sA + 128 * LR;
#pragma unroll
    for (int i = 0; i < 4; ++i) *reinterpret_cast<u32x4*>(sA + (crow + i * 32) * LR + cch * 8) = ra[i];
#pragma unroll
    for (int i = 0; i < NBCH; ++i) *reinterpret_cast<u32x4*>(sB + (crow + i * 32) * LR + cch * 8) = rb[i];
  };
  gload(0);
  __syncthreads();
  lstore(0);
  if (nk > 1) gload(1);
  __syncthreads();
  for (int kt = 0; kt < nk; ++kt) {
    const int cur = kt & 1;
    if (kt + 1 < nk) lstore(cur ^ 1);
    if (kt + 2 < nk) gload(kt + 2);
    const u16* sA = lds + cur * BUF;
    const u16* sB = sA + 128 * LR;
#pragma unroll
    for (int ks = 0; ks < 2; ++ks) {
      bf16x8 a[4], b[NT];
#pragma unroll
      for (int m = 0; m < 4; ++m) a[m] = *reinterpret_cast<const bf16x8*>(sA + (wr * 64 + m * 16 + fr) * LR + ks * 32 + fq * 8);
#pragma unroll
      for (int n = 0; n < NT; ++n) b[n] = *reinterpret_cast<const bf16x8*>(sB + (wc * 16 * NT + n * 16 + fr) * LR + ks * 32 + fq * 8);
#pragma unroll
      for (int m = 0; m < 4; ++m)
#pragma unroll
        for (int n = 0; n < NT; ++n) acc[m][n] = F16 ? mfma16h(a[m], b[n], acc[m][n]) : mfma16(a[m], b[n], acc[m][n]);
    }
    __syncthreads();
  }
}
template <int NT>
DI void zero_acc(f32x4 (&acc)[4][NT]) {
#pragma unroll
  for (int m = 0; m < 4; ++m)
#pragma unroll
    for (int n = 0; n < NT; ++n) acc[m][n] = f32x4{0.f, 0.f, 0.f, 0.f};
}


struct GemmOrder {
  int x, j, nb, cnt, NN, k;
  DI void init(int nM, int NN_) { x = blockIdx.x & 7; j = blockIdx.x >> 3; nb = gridDim.x >> 3; cnt = (nM - x + 7) >> 3; NN = NN_; k = 0; }
  DI bool next(int& mt, int& nt) {
    for (;;) {
      const int s = j + nb * k; ++k;
      const int g = s / (4 * NN), r = s - g * (4 * NN);
      if (g * 4 >= cnt) return false;
      const int i = g * 4 + (r & 3);
      if (i >= cnt) continue;
      mt = x + 8 * i; nt = r >> 2; return true;
    }
  }
};
template <bool F16, bool PERM = false>
DI void transpose_w(const float* __restrict__ W, int K, int N, int n0, int ncount, u16* __restrict__ WT, int gtid, int gstride) {
  const int total = ncount * (K >> 3);
  for (int idx0 = gtid; idx0 < total; idx0 += 2 * gstride) {
    float f[2][8];
    int nn[2], kk[2];
#pragma unroll
    for (int u = 0; u < 2; ++u) {
      const int idx = idx0 + u * gstride < total ? idx0 + u * gstride : idx0;
      const int n = idx % ncount, kb = idx / ncount;
      nn[u] = n; kk[u] = kb;
      int nsrc = n;
      if (PERM) { const int ntile = n >> 7, r = n & 127, wc = r >> 6, sub = (r >> 4) & 3, ff = r & 15; nsrc = (sub >= 2 ? 1024 : 0) + ntile * 64 + wc * 32 + (sub & 1) * 16 + ff; }
      const float* src = W + (size_t)(kb * 8) * N + n0 + nsrc;
#pragma unroll
      for (int j = 0; j < 8; ++j) f[u][j] = src[(size_t)j * N];
    }
#pragma unroll
    for (int u = 0; u < 2; ++u) {
      if (u == 1 && idx0 + gstride >= total) break;
      uint4 o;
      if (F16) { o.x = pack2h(f[u][0], f[u][1]); o.y = pack2h(f[u][2], f[u][3]); o.z = pack2h(f[u][4], f[u][5]); o.w = pack2h(f[u][6], f[u][7]); }
      else { o.x = pack2(f[u][0], f[u][1]); o.y = pack2(f[u][2], f[u][3]); o.z = pack2(f[u][4], f[u][5]); o.w = pack2(f[u][6], f[u][7]); }
      *reinterpret_cast<uint4*>(WT + (size_t)nn[u] * K + kk[u] * 8) = o;
    }
  }
}

__device__ void phase_prep(const Params& p, char* lds) {
  const int gtid = blockIdx.x * 256 + tidx(), gstride = gridDim.x * 256;
  for (int l = 0; l < 2; ++l) {
    transpose_w<true>(p.w_in + (size_t)l * 1024 * D_IN, 1024, D_IN, 0, N_IN1, ((u16*)(p.ws + WS_WinT)) + (size_t)l * N_IN1P * 1024, gtid, gstride);
    transpose_w<true, true>(p.w_in + (size_t)l * 1024 * D_IN, 1024, D_IN, N_IN1, 2048, ((u16*)(p.ws + WS_WgT)) + (size_t)l * 2048 * 1024, gtid, gstride);
    transpose_w<false>(p.w_glu + (size_t)l * 512 * 512, 512, 512, 0, 512, ((u16*)(p.ws + WS_WgluT)) + (size_t)l * 512 * 512, gtid, gstride);
    transpose_w<false>(p.w_ps + (size_t)l * 512 * 1024, 512, 1024, 0, 1024, ((u16*)(p.ws + WS_WpsT)) + (size_t)l * 1024 * 512, gtid, gstride);
    transpose_w<false>(p.w_pa + (size_t)l * 512 * 1024, 512, 1024, 0, 1024, ((u16*)(p.ws + WS_WpaT)) + (size_t)l * 1024 * 512, gtid, gstride);
    transpose_w<false>(p.w_o + (size_t)l * 1024 * 1024, 1024, 1024, 0, 1024, ((u16*)(p.ws + WS_WoT)) + (size_t)l * 1024 * 1024, gtid, gstride);
  }
  for (int idx = gtid; idx < 2 * 32 * 64; idx += gstride) {
    const int lg = idx >> 6, pp = idx & 63;
    const float are = p.a_re[idx], aim = p.a_im[idx];
    const float dt = expf(p.log_dt[lg]);
    const float mag = expf(are * dt), ang = aim * dt;
    const float kk = rintf(ang * 0.15915494309189535f);
    float r = fmaf(-kk, 6.2831854820251465f, ang);
    r = fmaf(-kk, -1.7484556e-07f, r);
    const float cs = cosf(r), sn = sinf(r);
    const float abr = mag * cs, abi = mag * sn;
    const float den = are * are + aim * aim;
    const float nr = abr - 1.f, ni = abi;
    const float fre = (nr * are + ni * aim) / den, fim = (ni * are - nr * aim) / den;
    ((float*)(p.ws + WS_ab))[idx * 2] = abr; ((float*)(p.ws + WS_ab))[idx * 2 + 1] = abi;
#pragma unroll
    for (int n = 0; n < 16; ++n) {
      const float br = p.b_re[(size_t)idx * 16 + n], bi = p.b_im[(size_t)idx * 16 + n];
      ((float*)(p.ws + WS_BbF))[(((size_t)lg * 2 + 0) * 16 + n) * 64 + pp] = fre * br - fim * bi;
      ((float*)(p.ws + WS_BbF))[(((size_t)lg * 2 + 1) * 16 + n) * 64 + pp] = fre * bi + fim * br;
      ((u16*)(p.ws + WS_Bmat))[((size_t)lg * 128 + pp) * 16 + n] = f2bf(fre * br - fim * bi);
      ((u16*)(p.ws + WS_Bmat))[((size_t)lg * 128 + 64 + pp) * 16 + n] = f2bf(fre * bi + fim * br);
      ((u16*)(p.ws + WS_Cmat))[((size_t)lg * 16 + n) * 128 + pp] = f2bf(p.c_re[((size_t)lg * 16 + n) * 64 + pp]);
      ((u16*)(p.ws + WS_Cmat))[((size_t)lg * 16 + n) * 128 + 64 + pp] = f2bf(-p.c_im[((size_t)lg * 16 + n) * 64 + pp]);
    }
  }
  float* red = reinterpret_cast<float*>(lds);
  for (int u = blockIdx.x; u < 192; u += gridDim.x) {
    const int l = u / 96, cg_ = u % 96;
    const int col = tidx() & 31, ks = tidx() >> 5;
    float acc[24];
#pragma unroll
    for (int r = 0; r < 24; ++r) acc[r] = 0.f;
    const float* wm = p.w_mod + (size_t)l * 1024 * 3072 + cg_ * 32 + col;
    for (int k = ks * 128; k < ks * 128 + 128; ++k) {
      const float w = wm[(size_t)k * 3072];
#pragma unroll
      for (int r = 0; r < 24; ++r) {
        const float c = r < 8 ? p.c_prompt[r * 1024 + k] : p.c_sample[(r - 8) * 1024 + k];
        acc[r] = fmaf(siluf_(c), w, acc[r]);
      }
    }
    __syncthreads();
#pragma unroll
    for (int r = 0; r < 24; ++r) red[(ks * 24 + r) * 32 + col] = acc[r];
    __syncthreads();
    for (int o = tidx(); o < 768; o += 256) {
      const int r = o >> 5, c = o & 31;
      float s = p.b_mod[l * 3072 + cg_ * 32 + c];
#pragma unroll
      for (int k8 = 0; k8 < 8; ++k8) s += red[(k8 * 24 + r) * 32 + c];
      ((float*)(p.ws + WS_mod))[((size_t)l * 24 + r) * 3072 + cg_ * 32 + c] = s;
    }
  }
}

__device__ void phase_norm(const Params& p, int l) {
  const int wave = tidx() >> 6, lane = tidx() & 63;
  const int gw = blockIdx.x * 4 + wave, nw = gridDim.x * 4;
  const float* gn = p.g_norm + l * 1024;
  for (int R0 = gw; R0 < NTOK; R0 += 2 * nw) {
    float4 v[2][4];
    float ss[2] = {0.f, 0.f};
    const int Rr[2] = {R0, R0 + nw < NTOK ? R0 + nw : R0};
#pragma unroll
    for (int r = 0; r < 2; ++r) {
      const float* x = xin_row(p, l, Rr[r]);
#pragma unroll
      for (int i = 0; i < 4; ++i) v[r][i] = *reinterpret_cast<const float4*>(x + i * 256 + lane * 4);
    }
    float4 g4[4], sh[2][4], sc[2][4];
#pragma unroll
    for (int i = 0; i < 4; ++i) g4[i] = *reinterpret_cast<const float4*>(gn + i * 256 + lane * 4);
#pragma unroll
    for (int r = 0; r < 2; ++r) {
      const float* md = ((float*)(p.ws + WS_mod)) + ((size_t)l * 24 + batch_of(Rr[r])) * 3072;
#pragma unroll
      for (int i = 0; i < 4; ++i) {
        sh[r][i] = *reinterpret_cast<const float4*>(md + i * 256 + lane * 4);
        sc[r][i] = *reinterpret_cast<const float4*>(md + 1024 + i * 256 + lane * 4);
      }
    }
#pragma unroll
    for (int r = 0; r < 2; ++r) {
#pragma unroll
      for (int i = 0; i < 4; ++i) ss[r] += v[r][i].x * v[r][i].x + v[r][i].y * v[r][i].y + v[r][i].z * v[r][i].z + v[r][i].w * v[r][i].w;
      ss[r] = wave_sum(ss[r]);
    }
#pragma unroll
    for (int r = 0; r < 2; ++r) {
      if (r == 1 && R0 + nw >= NTOK) break;
      const float rstd = rsqrtf(ss[r] * (1.f / 1024.f) + 1e-6f);
#pragma unroll
      for (int i = 0; i < 4; ++i) {
        const int c = i * 256 + lane * 4;
        uint2 o;
        o.x = pack2h(v[r][i].x * rstd * g4[i].x * (1.f + sc[r][i].x) + sh[r][i].x, v[r][i].y * rstd * g4[i].y * (1.f + sc[r][i].y) + sh[r][i].y);
        o.y = pack2h(v[r][i].z * rstd * g4[i].z * (1.f + sc[r][i].z) + sh[r][i].z, v[r][i].w * rstd * g4[i].w * (1.f + sc[r][i].w) + sh[r][i].w);
        *reinterpret_cast<uint2*>(((u16*)(p.ws + WS_H)) + (size_t)Rr[r] * 1024 + c) = o;
      }
    }
  }
  const int gtid = blockIdx.x * 256 + tidx(), gstride = gridDim.x * 256;
  {
    const float* ck = p.cache_k + (size_t)l * 16 * 4096 * 512;
    constexpr int NK = 16 * 4096 * 512 / 8;
    for (int idx = gtid; idx < NK; idx += 4 * gstride) {
      float4 a[4], c[4];
#pragma unroll
      for (int u = 0; u < 4; ++u) {
        const int i = idx + u * gstride < NK ? idx + u * gstride : idx;
        a[u] = *reinterpret_cast<const float4*>(ck + (size_t)i * 8); c[u] = *reinterpret_cast<const float4*>(ck + (size_t)i * 8 + 4);
      }
#pragma unroll
      for (int u = 0; u < 4; ++u) {
        const int i = idx + u * gstride;
        if (i < NK) {
          const size_t e = (size_t)i * 8;
          const int b = (int)(e / (4096 * 512)), rem = (int)(e % (4096 * 512));
          uint4 o; o.x = pack2(a[u].x, a[u].y); o.y = pack2(a[u].z, a[u].w); o.z = pack2(c[u].x, c[u].y); o.w = pack2(c[u].z, c[u].w);
          *reinterpret_cast<uint4*>(((u16*)(p.ws + WS_Ks)) + (size_t)b * KS_ROWS * 512 + rem) = o;
        }
      }
    }
    const float* cki = p.cache_kidx + (size_t)l * 16 * 4096 * 64;
    constexpr int NKI = 16 * 4096 * 64 / 8;
    for (int idx = gtid; idx < NKI; idx += 4 * gstride) {
      float4 a[4], c[4];
#pragma unroll
      for (int u = 0; u < 4; ++u) {
        const int i = idx + u * gstride < NKI ? idx + u * gstride : idx;
        a[u] = *reinterpret_cast<const float4*>(cki + (size_t)i * 8); c[u] = *reinterpret_cast<const float4*>(cki + (size_t)i * 8 + 4);
      }
#pragma unroll
      for (int u = 0; u < 4; ++u) {
        const int i = idx + u * gstride;
        if (i < NKI) {
          const size_t e = (size_t)i * 8;
          const int b = (int)(e / (4096 * 64)), rem = (int)(e % (4096 * 64));
          uint4 o; o.x = pack2h(a[u].x, a[u].y); o.y = pack2h(a[u].z, a[u].w); o.z = pack2h(c[u].x, c[u].y); o.w = pack2h(c[u].z, c[u].w);
          *reinterpret_cast<uint4*>(((u16*)(p.ws + WS_KIs)) + (size_t)b * KIS_ROWS * 64 + rem) = o;
        }
      }
    }
    const float* cv = p.cache_v + (size_t)l * 16 * 4096 * 512;
    constexpr int NV = 16 * 512 * 512;
    for (int idx = gtid; idx < NV; idx += 2 * gstride) {
      float f[2][8];
#pragma unroll
      for (int u = 0; u < 2; ++u) {
        const int i = idx + u * gstride < NV ? idx + u * gstride : idx;
        const int c = i & 511, sb = (i >> 9) & 511, b = i >> 18;
        const float* src = cv + ((size_t)b * 4096 + sb * 8) * 512 + c;
#pragma unroll
        for (int j = 0; j < 8; ++j) f[u][j] = src[(size_t)j * 512];
      }
#pragma unroll
      for (int u = 0; u < 2; ++u) {
        const int i = idx + u * gstride;
        if (i < NV) {
          const int c = i & 511, sb = (i >> 9) & 511, b = i >> 18;
          uint4 o; o.x = pack2(f[u][0], f[u][1]); o.y = pack2(f[u][2], f[u][3]); o.z = pack2(f[u][4], f[u][5]); o.w = pack2(f[u][6], f[u][7]);
          *reinterpret_cast<uint4*>(((u16*)(p.ws + WS_VTs)) + ((size_t)b * 512 + c) * KS_ROWS + sb * 8) = o;
        }
      }
    }
  }
}

__device__ void phase_inproj(const Params& p, int l, char* lds) {
  const int lane = tidx() & 63, wave = tidx() >> 6, wr = wave >> 1, wc = wave & 1, fr = lane & 15, fq = lane >> 4;
  GemmOrder ord; ord.init(NTOK / 128, 29);
  int mt, nt;
  while (ord.next(mt, nt)) {
    f32x4 acc[4][4];
    zero_acc<4>(acc);
    gemm_accum<4, true>(acc, ((u16*)(p.ws + WS_H)) + (size_t)mt * 128 * 1024, 1024, ((u16*)(p.ws + WS_WinT)) + ((size_t)l * N_IN1P + nt * 128) * 1024, 1024, 1024, reinterpret_cast<u16*>(lds));
    const int region = nt >> 2;
#pragma unroll
    for (int m = 0; m < 4; ++m) {
      const int R0 = mt * 128 + wr * 64 + m * 16 + fq * 4;
      const bool smp = R0 >= NP;
      const int rs = R0 - NP;
      const int b = smp ? (rs >> 5) : (R0 >> 13);
      const int s0 = smp ? (rs & 31) : (R0 & 8191);
#pragma unroll
      for (int n = 0; n < 4; ++n) {
        const int C = nt * 128 + wc * 64 + n * 16 + fr;
        const f32x4 v = acc[m][n];
        if (region == 0) {
#pragma unroll
          for (int j = 0; j < 4; ++j) ((u16*)(p.ws + WS_U))[(size_t)(R0 + j) * 512 + C] = f2bf(v[j]);
        } else if (region == 1) {
#pragma unroll
          for (int j = 0; j < 4; ++j) ((u16*)(p.ws + WS_ZS))[(size_t)(R0 + j) * 512 + (C - 512)] = f2bf(siluf_(v[j]));
        } else if (region == 2) {
#pragma unroll
          for (int j = 0; j < 4; ++j) ((u16*)(p.ws + WS_Q))[(size_t)(R0 + j) * 512 + (C - 1024)] = f2bf(v[j] * 0.18033688011112042f);
        } else if (region == 3) {
          const int cc = C - 1536;
          float* of = smp ? p.out + O_KS + (size_t)l * 262144 + (size_t)rs * 512 + cc : p.out + O_KP + (size_t)l * 33554432 + (size_t)R0 * 512 + cc;
          u16* ob = smp ? ((u16*)(p.ws + WS_Ks)) + ((size_t)b * KS_ROWS + 4096 + s0) * 512 + cc : ((u16*)(p.ws + WS_Kp)) + (size_t)R0 * 512 + cc;
#pragma unroll
          for (int j = 0; j < 4; ++j) { of[(size_t)j * 512] = v[j]; ob[(size_t)j * 512] = f2bf(v[j]); }
        } else if (region == 4) {
          const int cc = C - 2048;
          float* of = smp ? p.out + O_VS + (size_t)l * 262144 + (size_t)rs * 512 + cc : p.out + O_VP + (size_t)l * 33554432 + (size_t)R0 * 512 + cc;
#pragma unroll
          for (int j = 0; j < 4; ++j) of[(size_t)j * 512] = v[j];
          uint2 o; o.x = pack2(v[0], v[1]); o.y = pack2(v[2], v[3]);
          u16* ob = smp ? ((u16*)(p.ws + WS_VTs)) + ((size_t)b * 512 + cc) * KS_ROWS + 4096 + s0 : ((u16*)(p.ws + WS_VTp)) + ((size_t)b * 512 + cc) * 8192 + s0;
          *reinterpret_cast<uint2*>(ob) = o;
        } else if (region == 5) {
#pragma unroll
          for (int j = 0; j < 4; ++j) ((u16*)(p.ws + WS_ZA))[(size_t)(R0 + j) * 512 + (C - 2560)] = f2bf(siluf_(v[j]));
        } else if (region == 6) {
#pragma unroll
          for (int j = 0; j < 4; ++j) ((u16*)(p.ws + WS_QI))[(size_t)(R0 + j) * 512 + (C - 3072)] = f2h(v[j] * 0.125f);
        } else {
          if (C < 3648) {
            const int cc = C - 3584;
            float* of = smp ? p.out + O_KIS + (size_t)l * 32768 + (size_t)rs * 64 + cc : p.out + O_KIP + (size_t)l * 4194304 + (size_t)R0 * 64 + cc;
            u16* ob = smp ? ((u16*)(p.ws + WS_KIs)) + ((size_t)b * KIS_ROWS + 4096 + s0) * 64 + cc : ((u16*)(p.ws + WS_KIp)) + (size_t)R0 * 64 + cc;
#pragma unroll
            for (int j = 0; j < 4; ++j) { of[(size_t)j * 64] = v[j]; ob[(size_t)j * 64] = f2h(v[j]); }
          } else if (C < 3656) {
#pragma unroll
            for (int j = 0; j < 4; ++j) ((float*)(p.ws + WS_WI))[(size_t)(R0 + j) * 8 + (C - 3648)] = v[j] * 0.35355339059327373f;
          }
        }
      }
    }
  }
}

DI void ssm_unit(const Params& p, int l, int g, int row0, int T, float& hr, float& hi, bool write_y, u16* tile) {
  const int lane = tidx() & 63, fr = lane & 15, fq = lane >> 4;
  const int lg = l * 32 + g;
  const float abr = ((float*)(p.ws + WS_ab))[((size_t)lg * 64 + lane) * 2], abi = ((float*)(p.ws + WS_ab))[((size_t)lg * 64 + lane) * 2 + 1];
  const int ntile = T >> 4;
  bf16x8 am[8];
#pragma unroll
  for (int mt = 0; mt < 8; ++mt) am[mt] = fq < 2 ? ldg8(((u16*)(p.ws + WS_Bmat)) + ((size_t)lg * 128 + mt * 16 + fr) * 16 + fq * 8) : zero8();
  bf16x8 bu4[4];
#pragma unroll
  for (int nt = 0; nt < 4; ++nt) bu4[nt] = (fq < 2 && nt < ntile) ? ldg8(((u16*)(p.ws + WS_U)) + (size_t)(row0 + nt * 16 + fr) * 512 + g * 16 + fq * 8) : zero8();
#pragma unroll
  for (int nt = 0; nt < 4; ++nt) {
    if (nt >= ntile) break;
    const bf16x8 bu = bu4[nt];
#pragma unroll
    for (int mt = 0; mt < 8; ++mt) {
      const f32x4 a = mfma16(am[mt], bu, f32x4{0.f, 0.f, 0.f, 0.f});
      uint2 o; o.x = pack2(a[0], a[1]); o.y = pack2(a[2], a[3]);
      *reinterpret_cast<uint2*>(tile + (nt * 16 + fr) * 136 + mt * 16 + fq * 4) = o;
    }
  }
  wave_lds_sync();
  for (int t = 0; t < T; ++t) {
    const float br = bf2f(tile[t * 136 + lane]), bi = bf2f(tile[t * 136 + 64 + lane]);
    const float nhr = fmaf(abr, hr, fmaf(-abi, hi, br));
    const float nhi = fmaf(abr, hi, fmaf(abi, hr, bi));
    hr = nhr; hi = nhi;
    if (write_y) { tile[t * 136 + lane] = f2bf(hr); tile[t * 136 + 64 + lane] = f2bf(hi); }
  }
  if (!write_y) return;
  wave_lds_sync();
  bf16x8 cm[4];
#pragma unroll
  for (int ks = 0; ks < 4; ++ks) cm[ks] = ldg8(((u16*)(p.ws + WS_Cmat)) + ((size_t)lg * 16 + fr) * 128 + ks * 32 + fq * 8);
  const float dsk = p.d_skip[(size_t)lg * 16 + fr];
  u16 uv[4][4];
#pragma unroll
  for (int mt = 0; mt < 4; ++mt)
#pragma unroll
    for (int j = 0; j < 4; ++j) uv[mt][j] = mt < ntile ? ((u16*)(p.ws + WS_U))[(size_t)(row0 + mt * 16 + fq * 4 + j) * 512 + g * 16 + fr] : (u16)0;
  f32x4 ya[4];
#pragma unroll
  for (int mt = 0; mt < 4; ++mt) {
    f32x4 a = {0.f, 0.f, 0.f, 0.f};
    if (mt < ntile) {
#pragma unroll
      for (int ks = 0; ks < 4; ++ks) a = mfma16(*reinterpret_cast<const bf16x8*>(tile + (mt * 16 + fr) * 136 + ks * 32 + fq * 8), cm[ks], a);
    }
    ya[mt] = a;
  }
#pragma unroll
  for (int mt = 0; mt < 4; ++mt) {
    if (mt < ntile) {
#pragma unroll
      for (int j = 0; j < 4; ++j) {
        u16* up = ((u16*)(p.ws + WS_U)) + (size_t)(row0 + mt * 16 + fq * 4 + j) * 512 + g * 16 + fr;
        const float y = ya[mt][j] + dsk * bf2f(uv[mt][j]);
        *up = f2bf(geluf_(y));
      }
    }
  }
  wave_lds_sync();
}

__device__ void indexer_unit(const Params& p, bool smp, int b, int q0, int nkeys, char* lds) {
  const int tid = tidx(), lane = tid & 63, wave = tid >> 6, fr = lane & 15, fq = lane >> 4;
  constexpr int HROW = 1025;
  uint32_t* hist = reinterpret_cast<uint32_t*>(lds);
  u16* maskbuf = reinterpret_cast<u16*>(lds);
  constexpr int CAP0 = 512;
  uint32_t* candK = reinterpret_cast<uint32_t*>(lds + 16640);
  u16* candP = reinterpret_cast<u16*>(lds + 16640 + 16 * CAP0 * 4);
  uint32_t* s_pref = reinterpret_cast<uint32_t*>(lds + 65792);
  uint32_t* s_need = s_pref + 16;
  uint32_t* s_cnt = s_need + 16;
  uint32_t* s_cn = s_cnt + 16;
  uint32_t* s_flag = s_cn + 16;
  uint32_t* s_cand = s_flag + 16;
  constexpr int CAP = 16;
  constexpr int MB = 520;
  const int Rq0 = smp ? NP + b * 32 + q0 : b * 8192 + q0;
  const u16* KI = smp ? ((u16*)(p.ws + WS_KIs)) + (size_t)b * KIS_ROWS * 64 : ((u16*)(p.ws + WS_KIp)) + (size_t)b * 8192 * 64;
  const int ntiles = nkeys >> 4;

  bf16x8 aq[8][2];
#pragma unroll
  for (int h = 0; h < 8; ++h)
#pragma unroll
    for (int ks = 0; ks < 2; ++ks) aq[h][ks] = ldg8(((u16*)(p.ws + WS_QI)) + (size_t)(Rq0 + fr) * 512 + h * 64 + ks * 32 + fq * 8);
  float w[8];
#pragma unroll
  for (int h = 0; h < 8; ++h) w[h] = ((float*)(p.ws + WS_WI))[(size_t)(Rq0 + fr) * 8 + h];

  bf16x8 nb0 = zero8(), nb1 = zero8();
  auto load_keys = [&](int kt) {
    const u16* kp = KI + (size_t)(kt * 16 + fr) * 64 + fq * 8;
    nb0 = ldg8(kp); nb1 = ldg8(kp + 32);
  };
  auto score_keys = [&](int kt, uint32_t (&key)[4]) {
    const bf16x8 b0 = nb0, b1 = nb1;
    if (kt + 4 < ntiles) load_keys(kt + 4);
    float sc[4] = {0.f, 0.f, 0.f, 0.f};
#pragma unroll
    for (int h = 0; h < 8; ++h) {
      f32x4 a = mfma16h(b0, aq[h][0], f32x4{0.f, 0.f, 0.f, 0.f});
      a = mfma16h(b1, aq[h][1], a);
#pragma unroll
      for (int j = 0; j < 4; ++j) sc[j] = fmaf(w[h], __builtin_amdgcn_fmed3f(a[j], 0.f, 3.0e38f), sc[j]);
    }
#pragma unroll
    for (int j = 0; j < 4; ++j) {
      const uint32_t uu = __float_as_uint(sc[j]);
      key[j] = (uu & 0x80000000u) ? ~uu : (uu | 0x80000000u);
    }
  };

  __syncthreads();
  if (tid < 16) { s_pref[tid] = 0u; s_need[tid] = 256u; s_cn[tid] = 0u; if (tid == 0) { s_flag[0] = 0u; s_flag[1] = 0u; } }
  if (nkeys > 256) {
#pragma unroll 1
    for (int pass = 0; pass < 3; ++pass) {
      if (pass == 1 && s_flag[1] == 0u) break;
      if (pass == 2 && s_flag[0] == 0u) break;
      for (int i = tid; i < 16 * HROW / 4; i += 256) reinterpret_cast<uint4*>(hist)[i] = uint4{0u, 0u, 0u, 0u};
      __syncthreads();
      const uint32_t pref = s_pref[fr];
      const int mshift = pass == 0 ? 32 : (pass == 1 ? 21 : 10);
      const int bshift = pass == 0 ? 21 : (pass == 1 ? 10 : 0);
      const uint32_t bmask = pass == 2 ? 1023u : 2047u;
      if (wave < ntiles) load_keys(wave);
      for (int kt = wave; kt < ntiles; kt += 4) {
        uint32_t key[4];
        score_keys(kt, key);
#pragma unroll
        for (int j = 0; j < 4; ++j) {
          const bool match = pass == 0 ? true : ((key[j] >> mshift) == pref);
          if (match) {
            const uint32_t bin = (key[j] >> bshift) & bmask;
            atomicAdd(&hist[fr * HROW + (bin >> 1)], (bin & 1u) ? 0x10000u : 1u);
          }
        }
      }
      __syncthreads();
      {
        const int q = tid >> 4, part = tid & 15;
        const int nb = pass == 2 ? 1024 : 2048;
        const int per = nb >> 4;
        const uint32_t* hq = hist + q * HROW;
        uint32_t mysum = 0;
        for (int wd = (part * per) >> 1; wd < ((part + 1) * per) >> 1; ++wd) { const uint32_t x = hq[wd]; mysum += (x & 0xffffu) + (x >> 16); }
        uint32_t v = mysum;
#pragma unroll
        for (int d = 1; d < 16; d <<= 1) { const uint32_t t2 = __shfl_down(v, d, 16); if (part + d < 16) v += t2; }
        const uint32_t above = v - mysum;
        const uint32_t need = s_need[q];
        const uint32_t prefq = s_pref[q];
        __syncthreads();
        if (above < need && need <= above + mysum) {
          uint32_t c = above;
          for (int bin = (part + 1) * per - 1; bin >= part * per; --bin) {
            const uint32_t cnt = (hq[bin >> 1] >> ((bin & 1) * 16)) & 0xffffu;
            if (c + cnt >= need) {
              s_pref[q] = (prefq << (pass == 2 ? 10 : 11)) | (uint32_t)bin;
              s_need[q] = need - c;
              if (pass == 1) { s_cnt[q] = cnt; if (cnt > (uint32_t)CAP) s_flag[0] = 1u; }
              if (pass == 0 && cnt > (uint32_t)CAP0) s_flag[1] = 1u;
              break;
            }
            c += cnt;
          }
        }
        __syncthreads();
      }
    }
  } else {
    __syncthreads();
  }
  const bool fast0 = (nkeys > 256) && (s_flag[1] == 0u);
  const bool fast = (nkeys > 256) && !fast0 && (s_flag[0] == 0u);
  const uint32_t thr = s_pref[fr];
  __syncthreads();
  const int nw16 = smp ? 260 : ntiles;
  if (wave < ntiles) load_keys(wave);
  for (int kt = wave; kt < nw16; kt += 4) {
    uint32_t word = 0;
    if (kt < ntiles) {
      uint32_t key[4];
      score_keys(kt, key);
      if (fast0) {
#pragma unroll
        for (int j = 0; j < 4; ++j) {
          const uint32_t k11 = key[j] >> 21;
          word |= (k11 > thr ? 1u : 0u) << (fq * 4 + j);
          if (k11 == thr) {
            const uint32_t ci = atomicAdd(&s_cn[fr], 1u);
            if (ci < (uint32_t)CAP0) { candK[fr * CAP0 + ci] = key[j] & 0x1fffffu; candP[fr * CAP0 + ci] = (u16)(kt * 16 + fq * 4 + j); }
          }
        }
      } else if (fast) {
#pragma unroll
        for (int j = 0; j < 4; ++j) {
          const uint32_t k22 = key[j] >> 10;
          word |= (k22 > thr ? 1u : 0u) << (fq * 4 + j);
          if (k22 == thr) {
            const uint32_t ci = atomicAdd(&s_cn[fr], 1u);
            if (ci < (uint32_t)CAP) s_cand[fr * CAP + ci] = (key[j] & 1023u) | ((uint32_t)(kt * 16 + fq * 4 + j) << 10);
          }
        }
      } else {
#pragma unroll
        for (int j = 0; j < 4; ++j) word |= (key[j] >= thr ? 1u : 0u) << (fq * 4 + j);
      }
      word |= __shfl_xor(word, 16);
      word |= __shfl_xor(word, 32);
    }
    if (fq == 0) maskbuf[fr * MB + kt] = (u16)word;
  }
  __syncthreads();
  if (fast0) {
    const int q = tid >> 4, part = tid & 15;
    const uint32_t n = s_cn[q] < (uint32_t)CAP0 ? s_cn[q] : (uint32_t)CAP0, need = s_need[q];
    uint32_t T = 0;
    for (int bit = 20; bit >= 0; --bit) {
      const uint32_t trial = T | (1u << bit);
      uint32_t c = 0;
      for (uint32_t i = part; i < n; i += 16) c += (candK[q * CAP0 + i] >= trial) ? 1u : 0u;
      c += __shfl_xor(c, 1); c += __shfl_xor(c, 2); c += __shfl_xor(c, 4); c += __shfl_xor(c, 8);
      if (c >= need) T = trial;
    }
    for (uint32_t i = part; i < n; i += 16) {
      if (candK[q * CAP0 + i] >= T) {
        const uint32_t pos = candP[q * CAP0 + i];
        const uint32_t widx = (uint32_t)(q * MB) + (pos >> 4);
        atomicOr(reinterpret_cast<uint32_t*>(maskbuf) + (widx >> 1), (1u << (pos & 15u)) << ((widx & 1u) * 16u));
      }
    }
    __syncthreads();
  }
  if (fast) {
    if (tid < 16) {
      const uint32_t n = s_cn[tid] < (uint32_t)CAP ? s_cn[tid] : (uint32_t)CAP, need = s_need[tid];
      for (uint32_t i = 0; i < n; ++i) {
        const uint32_t ci = s_cand[tid * CAP + i], vi = ci & 1023u;
        uint32_t greater = 0;
        for (uint32_t k = 0; k < n; ++k) greater += ((s_cand[tid * CAP + k] & 1023u) > vi) ? 1u : 0u;
        if (greater < need) {
          const uint32_t pos = ci >> 10;
          maskbuf[tid * MB + (pos >> 4)] |= (u16)(1u << (pos & 15u));
        }
      }
    }
    __syncthreads();
  }
  {
    const int n8 = nw16 >> 2;
    for (int i = tid; i < 16 * n8; i += 256) {
      const int q = i / n8, c = i % n8;
      const uint2 vv = *reinterpret_cast<const uint2*>(maskbuf + q * MB + c * 4);
      u16* dst = smp ? ((u16*)(p.ws + WS_masks)) + (size_t)(b * 32 + q0 + q) * MS_ROW : ((u16*)(p.ws + WS_maskp)) + (size_t)(b * 8192 + q0 + q) * 512;
      *reinterpret_cast<uint2*>(dst + c * 4) = vv;
    }
  }
}

__device__ void ssm_local_scan(const Params& p, int l, int b, int c, int g) {
  const int lane = tidx() & 63;
  const int lg = l * 32 + g;
  const float abr = ((float*)(p.ws + WS_ab))[((size_t)lg * 64 + lane) * 2], abi = ((float*)(p.ws + WS_ab))[((size_t)lg * 64 + lane) * 2 + 1];
  float bbr[16], bbi[16];
#pragma unroll
  for (int n = 0; n < 16; ++n) {
    bbr[n] = ((float*)(p.ws + WS_BbF))[(((size_t)lg * 2 + 0) * 16 + n) * 64 + lane];
    bbi[n] = ((float*)(p.ws + WS_BbF))[(((size_t)lg * 2 + 1) * 16 + n) * 64 + lane];
  }
  float hr = 0.f, hi = 0.f;
  const u16* up = ((u16*)(p.ws + WS_U)) + ((size_t)b * 8192 + (size_t)c * 64) * 512 + g * 16;
  u32x4 cur[8], nxt[8];
#pragma unroll
  for (int k = 0; k < 4; ++k) {
    cur[2 * k] = *reinterpret_cast<const u32x4*>(up + (size_t)k * 512);
    cur[2 * k + 1] = *reinterpret_cast<const u32x4*>(up + (size_t)k * 512 + 8);
  }
  for (int t4 = 0; t4 < 16; ++t4) {
    if (t4 + 1 < 16) {
#pragma unroll
      for (int k = 0; k < 4; ++k) {
        nxt[2 * k] = *reinterpret_cast<const u32x4*>(up + (size_t)((t4 + 1) * 4 + k) * 512);
        nxt[2 * k + 1] = *reinterpret_cast<const u32x4*>(up + (size_t)((t4 + 1) * 4 + k) * 512 + 8);
      }
    }
#pragma unroll
    for (int k = 0; k < 4; ++k) {
      float br = 0.f, bi = 0.f;
#pragma unroll
      for (int h2 = 0; h2 < 2; ++h2) {
        const u32x4 w = cur[2 * k + h2];
#pragma unroll
        for (int d = 0; d < 4; ++d) {
          const float x0 = __uint_as_float(w[d] << 16), x1 = __uint_as_float(w[d] & 0xffff0000u);
          const int n = h2 * 8 + d * 2;
          br = fmaf(bbr[n], x0, br); bi = fmaf(bbi[n], x0, bi);
          br = fmaf(bbr[n + 1], x1, br); bi = fmaf(bbi[n + 1], x1, bi);
        }
      }
      const float nhr = fmaf(abr, hr, fmaf(-abi, hi, br));
      const float nhi = fmaf(abr, hi, fmaf(abi, hr, bi));
      hr = nhr; hi = nhi;
    }
#pragma unroll
    for (int k = 0; k < 8; ++k) cur[k] = nxt[k];
  }
  const size_t o = ((size_t)(b * 128 + c) * 32 + g) * 64 + lane;
  ((float*)(p.ws + WS_SlocR))[o] = hr; ((float*)(p.ws + WS_SlocI))[o] = hi;
}

__device__ void phase_ssmA_indexer(const Params& p, int l, char* lds) {
  const int wave = tidx() >> 6;
  const int x = blockIdx.x & 7, j = blockIdx.x >> 3, nb = gridDim.x >> 3;
  if (blockIdx.x < 32) indexer_unit(p, true, blockIdx.x >> 1, (blockIdx.x & 1) * 16, 4128, lds);
  for (int tlo = j; tlo < 256; tlo += nb) {
    const int th = 511 - tlo;
    indexer_unit(p, false, x, th * 16, ((th >> 2) + 1) * 64, lds);
    indexer_unit(p, false, x, tlo * 16, ((tlo >> 2) + 1) * 64, lds);
  }
  for (int u = blockIdx.x; u < 8192; u += gridDim.x) {
    const int wu = u * 4 + wave;
    ssm_local_scan(p, l, wu >> 12, (wu >> 5) & 127, wu & 31);
  }
}

DI bf16x8 pack8_bf16(float a0, float a1, float a2, float a3, float a4, float a5, float a6, float a7) {
  u32x4 r;
  asm("v_cvt_pk_bf16_f32 %0, %4, %5\n\tv_cvt_pk_bf16_f32 %1, %6, %7\n\tv_cvt_pk_bf16_f32 %2, %8, %9\n\tv_cvt_pk_bf16_f32 %3, %10, %11\n\ts_nop 1"
      : "=&v"(r[0]), "=&v"(r[1]), "=&v"(r[2]), "=&v"(r[3])
      : "v"(a0), "v"(a1), "v"(a2), "v"(a3), "v"(a4), "v"(a5), "v"(a6), "v"(a7));
  return __builtin_bit_cast(bf16x8, r);
}

__device__ void attn_unit(const Params& p, bool smp, int b, int chunk, int h, char* lds) {
  constexpr int LR = 72;
  constexpr int STG = 128 * LR;
  const int tid = tidx(), lane = tid & 63, wave = tid >> 6, fr = lane & 15, fq = lane >> 4;
  u16* sbase = reinterpret_cast<u16*>(lds);
  const int nq = smp ? 32 : 64;
  const int nkeys = smp ? 4128 : 64 * (chunk + 1);
  const int ntile = (nkeys + 63) >> 6;
  const int Rq0 = smp ? NP + b * 32 : b * 8192 + chunk * 64;
  const u16* Kb = (smp ? ((u16*)(p.ws + WS_Ks)) + (size_t)b * KS_ROWS * 512 : ((u16*)(p.ws + WS_Kp)) + (size_t)b * 8192 * 512) + h * 64;
  const int Sv = smp ? KS_ROWS : 8192;
  const u16* Vb = smp ? ((u16*)(p.ws + WS_VTs)) + ((size_t)b * 512 + h * 64) * KS_ROWS : ((u16*)(p.ws + WS_VTp)) + ((size_t)b * 512 + h * 64) * 8192;
  const bool active = wave * 16 < nq;
  const int qrow = active ? wave * 16 : 0;
  bf16x8 aq[2];
#pragma unroll
  for (int ks = 0; ks < 2; ++ks) aq[ks] = ldg8(((u16*)(p.ws + WS_Q)) + (size_t)(Rq0 + qrow + fr) * 512 + h * 64 + ks * 32 + fq * 8);
  const u16* mrow = smp ? ((u16*)(p.ws + WS_masks)) + (size_t)(b * 32 + qrow + fr) * MS_ROW
                        : ((u16*)(p.ws + WS_maskp)) + (size_t)(b * 8192 + chunk * 64 + qrow + fr) * 512;
  const int srow = tid >> 3, sch = tid & 7;
  u32x4 rk[2], rv[2];
  u32x2 mk;
  auto gload = [&](int kt) {
#pragma unroll
    for (int i = 0; i < 2; ++i) {
      rk[i] = *reinterpret_cast<const u32x4*>(Kb + (size_t)(kt * 64 + srow + i * 32) * 512 + sch * 8);
      rv[i] = *reinterpret_cast<const u32x4*>(Vb + (size_t)(srow + i * 32) * Sv + kt * 64 + sch * 8);
    }
    mk = *reinterpret_cast<const u32x2*>(mrow + kt * 4);
  };
  auto lstore = [&](int buf) {
    u16* sK = sbase + buf * STG;
    u16* sV = sK + 64 * LR;
#pragma unroll
    for (int i = 0; i < 2; ++i) {
      *reinterpret_cast<u32x4*>(sK + (srow + i * 32) * LR + sch * 8) = rk[i];
      *reinterpret_cast<u32x4*>(sV + (srow + i * 32) * LR + sch * 8) = rv[i];
    }
  };
  f32x4 Ot[4];
#pragma unroll
  for (int n = 0; n < 4; ++n) Ot[n] = f32x4{0.f, 0.f, 0.f, 0.f};
  float mrun = -1e29f, lrun = 0.f;
  gload(0);
  __syncthreads();
  lstore(0);
  u32x2 mcur = mk;
  if (ntile > 1) gload(1);
  __syncthreads();
  for (int kt = 0; kt < ntile; ++kt) {
    const int cur = kt & 1;
    const u32x2 mthis = mcur;
    if (kt + 1 < ntile) { lstore(cur ^ 1); mcur = mk; }
    if (kt + 2 < ntile) gload(kt + 2);
    if (active) {
      const u16* sK = sbase + cur * STG;
      const u16* sV = sK + 64 * LR;
      f32x4 st[4];
#pragma unroll
      for (int n = 0; n < 4; ++n) {
        f32x4 a = {0.f, 0.f, 0.f, 0.f};
#pragma unroll
        for (int ks = 0; ks < 2; ++ks) a = mfma16(*reinterpret_cast<const bf16x8*>(sK + (n * 16 + fr) * LR + ks * 32 + fq * 8), aq[ks], a);
        st[n] = a;
      }
      float mx = -1e30f;
#pragma unroll
      for (int n = 0; n < 4; ++n) {
        const uint32_t nib = ((n < 2 ? mthis[0] : mthis[1]) >> ((n & 1) * 16 + fq * 4)) & 15u;
#pragma unroll
        for (int j = 0; j < 4; ++j) {
          st[n][j] = (nib & (1u << j)) ? st[n][j] : -1e30f;
          mx = fmaxf(mx, st[n][j]);
        }
      }
      mx = fmaxf(mx, __shfl_xor(mx, 16));
      mx = fmaxf(mx, __shfl_xor(mx, 32));
      const float mnew = fmaxf(mrun, mx);
      const float alpha = __builtin_amdgcn_exp2f(mrun - mnew);
      mrun = mnew;
      float ps = 0.f;
#pragma unroll
      for (int n = 0; n < 4; ++n)
#pragma unroll
        for (int j = 0; j < 4; ++j) { st[n][j] = __builtin_amdgcn_exp2f(st[n][j] - mnew); ps += st[n][j]; }
      lrun = lrun * alpha + ps;
#pragma unroll
      for (int n = 0; n < 4; ++n)
#pragma unroll
        for (int j = 0; j < 4; ++j) Ot[n][j] *= alpha;
#pragma unroll
      for (int ks = 0; ks < 2; ++ks) {
        const bf16x8 pb = pack8_bf16(st[2 * ks][0], st[2 * ks][1], st[2 * ks][2], st[2 * ks][3],
                                     st[2 * ks + 1][0], st[2 * ks + 1][1], st[2 * ks + 1][2], st[2 * ks + 1][3]);
#pragma unroll
        for (int dt = 0; dt < 4; ++dt) {
          const u16* vr = sV + (dt * 16 + fr) * LR + ks * 32 + fq * 4;
          const u32x2 v0 = *reinterpret_cast<const u32x2*>(vr), v1 = *reinterpret_cast<const u32x2*>(vr + 16);
          const u32x4 vv = {v0[0], v0[1], v1[0], v1[1]};
          Ot[dt] = mfma16(__builtin_bit_cast(bf16x8, vv), pb, Ot[dt]);
        }
      }
    }
    __syncthreads();
  }
  if (active) {
    float ls = lrun;
    ls += __shfl_xor(ls, 16); ls += __shfl_xor(ls, 32);
    const float inv = 1.f / ls;
    const size_t ro = (size_t)(Rq0 + qrow + fr) * 512 + h * 64;
    u32x2 zz4[4];
#pragma unroll
    for (int dt = 0; dt < 4; ++dt) zz4[dt] = *reinterpret_cast<const u32x2*>(((u16*)(p.ws + WS_ZA)) + ro + dt * 16 + fq * 4);
#pragma unroll
    for (int dt = 0; dt < 4; ++dt) {
      const size_t o = ro + dt * 16 + fq * 4;
      const u32x2 zz = zz4[dt];
      const float z0 = __uint_as_float(zz[0] << 16), z1 = __uint_as_float(zz[0] & 0xffff0000u);
      const float z2 = __uint_as_float(zz[1] << 16), z3 = __uint_as_float(zz[1] & 0xffff0000u);
      u32x2 ov;
      ov[0] = pack2(Ot[dt][0] * inv * z0, Ot[dt][1] * inv * z1);
      ov[1] = pack2(Ot[dt][2] * inv * z2, Ot[dt][3] * inv * z3);
      *reinterpret_cast<u32x2*>(((u16*)(p.ws + WS_Q)) + o) = ov;
    }
  }
}

__device__ void phase_ssmB_attn(const Params& p, int l, char* lds) {
  const int x = blockIdx.x & 7, j = blockIdx.x >> 3, nb = gridDim.x >> 3;
  if (blockIdx.x >= gridDim.x - 64) {
    const int t = (gridDim.x - 1 - blockIdx.x) * 256 + tidx();
    const int pp = t & 63, g = (t >> 6) & 31, b = t >> 11;
    float ar = ((float*)(p.ws + WS_ab))[((size_t)(l * 32 + g) * 64 + pp) * 2], ai = ((float*)(p.ws + WS_ab))[((size_t)(l * 32 + g) * 64 + pp) * 2 + 1];
#pragma unroll
    for (int i = 0; i < 6; ++i) { const float nr = ar * ar - ai * ai, ni = 2.f * ar * ai; ar = nr; ai = ni; }
    float hr = 0.f, hi = 0.f;
    for (int c8 = 0; c8 < 128; c8 += 8) {
      float sr[8], si[8];
#pragma unroll
      for (int k = 0; k < 8; ++k) {
        const size_t o = ((size_t)(b * 128 + c8 + k) * 32 + g) * 64 + pp;
        sr[k] = ((float*)(p.ws + WS_SlocR))[o]; si[k] = ((float*)(p.ws + WS_SlocI))[o];
      }
#pragma unroll
      for (int k = 0; k < 8; ++k) {
        const size_t o = ((size_t)(b * 128 + c8 + k) * 32 + g) * 64 + pp;
        ((float*)(p.ws + WS_HstR))[o] = hr; ((float*)(p.ws + WS_HstI))[o] = hi;
        const float nhr = ar * hr - ai * hi + sr[k], nhi = ar * hi + ai * hr + si[k];
        hr = nhr; hi = nhi;
      }
    }
    p.out[O_SRP + (size_t)l * 16384 + (size_t)(b * 32 + g) * 64 + pp] = hr;
    p.out[O_SIP + (size_t)l * 16384 + (size_t)(b * 32 + g) * 64 + pp] = hi;
  }
  if (blockIdx.x < 128) attn_unit(p, true, blockIdx.x >> 3, 0, blockIdx.x & 7, lds);
  for (int pi = 0; pi < 8; ++pi) {
    const int pair = x + 8 * pi, b = pair >> 3, h = pair & 7;
    for (int c = j; c < 64; c += nb) {
      attn_unit(p, false, b, 127 - c, h, lds);
      attn_unit(p, false, b, c, h, lds);
    }
  }
}

__device__ void phase_ssmC(const Params& p, int l, char* lds) {
  const int wave = tidx() >> 6, lane = tidx() & 63;
  const int NU = (32768 + 512) / 4;
  for (int u = blockIdx.x; u < NU; u += gridDim.x) {
    const int wu = u * 4 + wave;
    u16* tile = reinterpret_cast<u16*>(lds) + wave * (64 * 136);
    if (wu < 32768) {
      const int g = wu & 31, c = (wu >> 5) & 127, b = wu >> 12;
      const size_t o = ((size_t)(b * 128 + c) * 32 + g) * 64 + lane;
      float hr = ((float*)(p.ws + WS_HstR))[o], hi = ((float*)(p.ws + WS_HstI))[o];
      ssm_unit(p, l, g, b * 8192 + c * 64, 64, hr, hi, true, tile);
    } else {
      const int i = wu - 32768;
      const int g = i & 31, b = i >> 5;
      const size_t si = ((size_t)(l * 16 + b) * 32 + g) * 64 + lane;
      float hr = p.st_re[si], hi = p.st_im[si];
      ssm_unit(p, l, g, NP + b * 32, 32, hr, hi, true, tile);
      p.out[O_SRS + si] = hr;
      p.out[O_SIS + si] = hi;
    }
  }
}

__device__ void phase_glu(const Params& p, int l, char* lds) {
  const int lane = tidx() & 63, wave = tidx() >> 6, wr = wave >> 1, wc = wave & 1, fr = lane & 15, fq = lane >> 4;
  GemmOrder ord; ord.init(NTOK / 128, 4);
  int mt, nt;
  while (ord.next(mt, nt)) {
    f32x4 acc[4][4];
    zero_acc<4>(acc);
    gemm_accum<4>(acc, ((u16*)(p.ws + WS_U)) + (size_t)mt * 128 * 512, 512, ((u16*)(p.ws + WS_WgluT)) + ((size_t)l * 512 + nt * 128) * 512, 512, 512, reinterpret_cast<u16*>(lds));
    float bg[4];
#pragma unroll
    for (int n = 0; n < 4; ++n) bg[n] = p.b_glu[l * 512 + nt * 128 + wc * 64 + n * 16 + fr];
#pragma unroll
    for (int m = 0; m < 4; ++m) {
      u16 yv[4][4], zv[4][4];
#pragma unroll
      for (int n = 0; n < 4; ++n)
#pragma unroll
        for (int j = 0; j < 4; ++j) {
          const size_t o = (size_t)(mt * 128 + wr * 64 + m * 16 + fq * 4 + j) * 512 + nt * 128 + wc * 64 + n * 16 + fr;
          yv[n][j] = ((u16*)(p.ws + WS_U))[o];
          zv[n][j] = ((u16*)(p.ws + WS_ZS))[o];
        }
#pragma unroll
      for (int n = 0; n < 4; ++n)
#pragma unroll
        for (int j = 0; j < 4; ++j) {
          const size_t o = (size_t)(mt * 128 + wr * 64 + m * 16 + fq * 4 + j) * 512 + nt * 128 + wc * 64 + n * 16 + fr;
          ((u16*)(p.ws + WS_ZS))[o] = f2bf(bf2f(yv[n][j]) * sigmoidf_(acc[m][n][j] + bg[n]) * bf2f(zv[n][j]));
        }
    }
  }
}
__device__ void phase_merge(const Params& p, int l, char* lds) {
  const int lane = tidx() & 63, wave = tidx() >> 6, wr = wave >> 1, wc = wave & 1, fr = lane & 15, fq = lane >> 4;
  u16* L = reinterpret_cast<u16*>(lds);
  GemmOrder ord; ord.init(NTOK / 128, 16);
  int mt, nt;
  while (ord.next(mt, nt)) {
    f32x4 G[4][4];
    zero_acc<4>(G);
    gemm_accum<4, true>(G, ((u16*)(p.ws + WS_H)) + (size_t)mt * 128 * 1024, 1024, ((u16*)(p.ws + WS_WgT)) + ((size_t)l * 2048 + nt * 128) * 1024, 1024, 1024, L);
#pragma unroll
    for (int m = 0; m < 4; ++m)
#pragma unroll
      for (int n = 0; n < 4; ++n)
#pragma unroll
        for (int j = 0; j < 4; ++j) G[m][n][j] = sigmoidf_(G[m][n][j]);
    f32x4 acc[4][2];
    zero_acc<2>(acc);
    gemm_accum<2>(acc, ((u16*)(p.ws + WS_ZS)) + (size_t)mt * 128 * 512, 512, ((u16*)(p.ws + WS_WpsT)) + ((size_t)l * 1024 + nt * 64) * 512, 512, 512, L);
#pragma unroll
    for (int m = 0; m < 4; ++m)
#pragma unroll
      for (int n = 0; n < 2; ++n)
#pragma unroll
        for (int j = 0; j < 4; ++j) G[m][n][j] *= acc[m][n][j];
    zero_acc<2>(acc);
    gemm_accum<2>(acc, ((u16*)(p.ws + WS_Q)) + (size_t)mt * 128 * 512, 512, ((u16*)(p.ws + WS_WpaT)) + ((size_t)l * 1024 + nt * 64) * 512, 512, 512, L);
#pragma unroll
    for (int m = 0; m < 4; ++m)
#pragma unroll
      for (int n = 0; n < 2; ++n) {
        const int C = nt * 64 + wc * 32 + n * 16 + fr;
#pragma unroll
        for (int j = 0; j < 4; ++j) {
          const float v = G[m][n][j] + G[m][n + 2][j] * acc[m][n][j];
          ((u16*)(p.ws + WS_U))[(size_t)(mt * 128 + wr * 64 + m * 16 + fq * 4 + j) * 1024 + C] = f2bf(v);
        }
      }
  }
}

__device__ void phase_out(const Params& p, int l, char* lds) {
  const int lane = tidx() & 63, wave = tidx() >> 6, wr = wave >> 1, wc = wave & 1, fr = lane & 15, fq = lane >> 4;
  GemmOrder ord; ord.init(NTOK / 128, 8);
  int mt, nt;
  while (ord.next(mt, nt)) {
    f32x4 acc[4][4];
    zero_acc<4>(acc);
    gemm_accum<4>(acc, ((u16*)(p.ws + WS_U)) + (size_t)mt * 128 * 1024, 1024, ((u16*)(p.ws + WS_WoT)) + ((size_t)l * 1024 + nt * 128) * 1024, 1024, 1024, reinterpret_cast<u16*>(lds));
    float xo[4][4][4];
#pragma unroll
    for (int m = 0; m < 4; ++m) {
      const int R0 = mt * 128 + wr * 64 + m * 16 + fq * 4;
#pragma unroll
      for (int j = 0; j < 4; ++j) {
        const float* xr = xin_row(p, l, R0 + j) + nt * 128 + wc * 64 + fr;
#pragma unroll
        for (int n = 0; n < 4; ++n) xo[m][n][j] = xr[n * 16];
      }
    }
#pragma unroll
    for (int m = 0; m < 4; ++m) {
      const int R0 = mt * 128 + wr * 64 + m * 16 + fq * 4;
      const float* gate = ((float*)(p.ws + WS_mod)) + ((size_t)l * 24 + batch_of(R0)) * 3072 + 2048;
#pragma unroll
      for (int n = 0; n < 4; ++n) {
        const int C = nt * 128 + wc * 64 + n * 16 + fr;
        const float gv = gate[C];
#pragma unroll
        for (int j = 0; j < 4; ++j) p.out[(size_t)(R0 + j) * 1024 + C] = xo[m][n][j] + gv * acc[m][n][j];
      }
    }
  }
}

__device__ void phase_final(const Params& p) {
  const int wave = tidx() >> 6, lane = tidx() & 63;
  const int gw = blockIdx.x * 4 + wave, nw = gridDim.x * 4;
  float4 g4[4];
#pragma unroll
  for (int i = 0; i < 4; ++i) g4[i] = *reinterpret_cast<const float4*>(p.g_final + i * 256 + lane * 4);
  for (int R0 = gw; R0 < NTOK; R0 += 2 * nw) {
    const int Rr[2] = {R0, R0 + nw < NTOK ? R0 + nw : R0};
    float4 v[2][4];
    float ss[2] = {0.f, 0.f};
#pragma unroll
    for (int r = 0; r < 2; ++r)
#pragma unroll
      for (int i = 0; i < 4; ++i) v[r][i] = *reinterpret_cast<const float4*>(p.out + (size_t)Rr[r] * 1024 + i * 256 + lane * 4);
#pragma unroll
    for (int r = 0; r < 2; ++r) {
#pragma unroll
      for (int i = 0; i < 4; ++i) ss[r] += v[r][i].x * v[r][i].x + v[r][i].y * v[r][i].y + v[r][i].z * v[r][i].z + v[r][i].w * v[r][i].w;
      ss[r] = wave_sum(ss[r]);
    }
#pragma unroll
    for (int r = 0; r < 2; ++r) {
      if (r == 1 && R0 + nw >= NTOK) break;
      const float rstd = rsqrtf(ss[r] * (1.f / 1024.f) + 1e-6f);
#pragma unroll
      for (int i = 0; i < 4; ++i) {
        float4 o;
        o.x = v[r][i].x * rstd * g4[i].x; o.y = v[r][i].y * rstd * g4[i].y; o.z = v[r][i].z * rstd * g4[i].z; o.w = v[r][i].w * rstd * g4[i].w;
        *reinterpret_cast<float4*>(p.out + (size_t)Rr[r] * 1024 + i * 256 + lane * 4) = o;
      }
    }
  }
}

__global__ void __launch_bounds__(256, 2) fwd_megakernel(Params p) {
  extern __shared__ __attribute__((aligned(16))) char lds[];
  cg::grid_group grid = cg::this_grid();
  for (int ph = p.phase_lo; ph <= p.phase_hi; ++ph) {
    if (ph > p.phase_lo) grid.sync();
    Params q = p;
#define LAUNDER(f) asm volatile("" : "+s"(q.f))
    LAUNDER(x_prompt); LAUNDER(x_sample); LAUNDER(cache_k); LAUNDER(cache_v); LAUNDER(cache_kidx); LAUNDER(st_re); LAUNDER(st_im);
    LAUNDER(c_prompt); LAUNDER(c_sample); LAUNDER(w_mod); LAUNDER(b_mod); LAUNDER(g_norm); LAUNDER(w_in); LAUNDER(a_re); LAUNDER(a_im);
    LAUNDER(log_dt); LAUNDER(b_re); LAUNDER(b_im); LAUNDER(c_re); LAUNDER(c_im); LAUNDER(d_skip); LAUNDER(w_glu); LAUNDER(b_glu);
    LAUNDER(w_ps); LAUNDER(w_pa); LAUNDER(w_o); LAUNDER(g_final); LAUNDER(out); LAUNDER(ws);
#undef LAUNDER
    if (ph == 0) phase_prep(q, lds);
    else if (ph == NPHASE - 1) phase_final(q);
    else {
      const int l = (ph - 1) >> 3, s = (ph - 1) & 7;
      switch (s) {
        case 0: phase_norm(q, l); break;
        case 1: phase_inproj(q, l, lds); break;
        case 2: phase_ssmA_indexer(q, l, lds); break;
        case 3: phase_ssmB_attn(q, l, lds); break;
        case 4: phase_ssmC(q, l, lds); break;
        case 5: phase_glu(q, l, lds); break;
        case 6: phase_merge(q, l, lds); break;
        default: phase_out(q, l, lds); break;
      }
    }
  }
}

extern "C" void kernel_launch(void* const* d_in, const int* in_sizes, int n_in, void* d_out, int out_size, void* d_ws, size_t ws_size,
                              hipStream_t stream) {
  static int grid_blocks = 0;
  if (!grid_blocks) {
    int dev = 0, cus = 0, per_cu = 0;
    hipGetDevice(&dev);
    hipDeviceGetAttribute(&cus, hipDeviceAttributeMultiprocessorCount, dev);
    hipFuncSetAttribute((const void*)fwd_megakernel, hipFuncAttributeMaxDynamicSharedMemorySize, LDS_BYTES);
    hipOccupancyMaxActiveBlocksPerMultiprocessor(&per_cu, (const void*)fwd_megakernel, 256, LDS_BYTES);
    if (per_cu < 1) per_cu = 1;
    if (per_cu > 2) per_cu = 2;
    grid_blocks = cus * per_cu;
  }
  Params p{};
  const float* const* in = reinterpret_cast<const float* const*>(d_in);
  p.x_prompt = in[0]; p.x_sample = in[1]; p.cache_k = in[2]; p.cache_v = in[3]; p.cache_kidx = in[4];
  p.st_re = in[5]; p.st_im = in[6]; p.c_prompt = in[7]; p.c_sample = in[8];
  p.w_mod = in[9]; p.b_mod = in[10]; p.g_norm = in[11]; p.w_in = in[12]; p.a_re = in[13]; p.a_im = in[14]; p.log_dt = in[15];
  p.b_re = in[16]; p.b_im = in[17]; p.c_re = in[18]; p.c_im = in[19]; p.d_skip = in[20];
  p.w_glu = in[21]; p.b_glu = in[22]; p.w_ps = in[23]; p.w_pa = in[24]; p.w_o = in[25]; p.g_final = in[26];
  p.out = (float*)d_out;
  p.ws = (char*)d_ws;
  if (WS_TOTAL > ws_size) fprintf(stderr, "kernel_launch: workspace too small: need %zu have %zu\n", (size_t)WS_TOTAL, ws_size);
#if MULTI_LAUNCH
  for (int ph = 0; ph < NPHASE; ++ph) {
    p.phase_lo = ph; p.phase_hi = ph;
    hipLaunchKernelGGL(fwd_megakernel, dim3(grid_blocks), dim3(256), LDS_BYTES, stream, p);
  }
#else
  p.phase_lo = 0; p.phase_hi = NPHASE - 1;
  void* args[] = {&p};
  hipError_t e = hipLaunchCooperativeKernel((void*)fwd_megakernel, dim3(grid_blocks), dim3(256), args, LDS_BYTES, stream);
  if (e != hipSuccess) fprintf(stderr, "cooperative launch failed: %s (grid %d)\n", hipGetErrorString(e), grid_blocks);
#endif
}
```
